# Optimizing an MI355X kernel written in HIP

```python
import jax, jax.numpy as jnp
from jax import lax
import numpy as np

D_MODEL = 1024
BATCH = 8
SEQ = 2048
DEPTH = 2

MEM_LEN = 256
HEAD_DIM = 64
SB_HEADS = 8
FOX_HEADS = 8
MEM_HEADS = 4
SB_WIDTH = SB_HEADS * HEAD_DIM
FOX_WIDTH = FOX_HEADS * HEAD_DIM
MEM_WIDTH = MEM_HEADS * HEAD_DIM
MIX_WIDTH = SB_WIDTH + FOX_WIDTH + MEM_WIDTH
TOTAL_HEADS = SB_HEADS + FOX_HEADS + MEM_HEADS
IN_WIDTH = 3 * SB_WIDTH + 3 * FOX_WIDTH + FOX_HEADS + MEM_WIDTH + MIX_WIDTH
Q_BLOCK = 128
EPS = 1e-6

kernel_name = "hybrid_stickbreak_fox_memxattn"


def rmsnorm(x, g):
    xf = x.astype(jnp.float32)
    y = xf * lax.rsqrt(jnp.mean(xf * xf, axis=-1, keepdims=True) + EPS)
    return (y * g.astype(jnp.float32)).astype(x.dtype)


def split_heads(t, n_heads):
    b, s, _ = t.shape
    return t.reshape(b, s, n_heads, HEAD_DIM).transpose(0, 2, 1, 3)


def merge_heads(t):
    b, h, s, d = t.shape
    return t.transpose(0, 2, 1, 3).reshape(b, s, h * d)


def stick_breaking_attention(q, k, v):
    seq = q.shape[2]
    scale = HEAD_DIM ** -0.5
    outs = []
    for i in range(seq // Q_BLOCK):
        start, end = i * Q_BLOCK, (i + 1) * Q_BLOCK
        qb, kb, vb = q[:, :, start:end], k[:, :, :end], v[:, :, :end]
        z = jnp.einsum('bhqd,bhkd->bhqk', qb, kb,
                       preferred_element_type=jnp.float32) * scale
        q_pos = start + jnp.arange(Q_BLOCK)[:, None]
        k_pos = jnp.arange(end)[None, :]
        strict = k_pos < q_pos
        log_fail = jnp.where(strict, -jax.nn.softplus(z), 0.0)
        suffix = lax.cumsum(log_fail, axis=3, reverse=True) - log_fail
        log_a = jax.nn.log_sigmoid(z) + suffix
        a = jnp.where(strict, jnp.exp(log_a), 0.0)
        outs.append(jnp.einsum('bhqk,bhkd->bhqd', a.astype(vb.dtype), vb))
    return jnp.concatenate(outs, axis=2)


def forgetting_attention(q, k, v, log_f_cum):
    seq = q.shape[2]
    scale = HEAD_DIM ** -0.5
    outs = []
    for i in range(seq // Q_BLOCK):
        start, end = i * Q_BLOCK, (i + 1) * Q_BLOCK
        qb, kb, vb = q[:, :, start:end], k[:, :, :end], v[:, :, :end]
        logits = jnp.einsum('bhqd,bhkd->bhqk', qb, kb,
                            preferred_element_type=jnp.float32) * scale
        logits = logits + log_f_cum[:, :, start:end, None] - log_f_cum[:, :, None, :end]
        q_pos = start + jnp.arange(Q_BLOCK)[:, None]
        k_pos = jnp.arange(end)[None, :]
        logits = jnp.where(k_pos <= q_pos, logits, -jnp.inf)
        p = jax.nn.softmax(logits, axis=-1)
        outs.append(jnp.einsum('bhqk,bhkd->bhqd', p.astype(vb.dtype), vb))
    return jnp.concatenate(outs, axis=2)


def memory_attention(q, k, v):
    logits = jnp.einsum('bhqd,bhkd->bhqk', q, k,
                        preferred_element_type=jnp.float32) * (HEAD_DIM ** -0.5)
    p = jax.nn.softmax(logits, axis=-1)
    return jnp.einsum('bhqk,bhkd->bhqd', p.astype(v.dtype), v)


def setup_inputs(seed: int = 0) -> dict:
    key = jax.random.key(seed)
    ks = jax.random.split(key, 11)
    f32 = jnp.float32
    x = jax.random.normal(ks[0], (BATCH, SEQ, D_MODEL), f32)
    mem = jax.random.normal(ks[1], (BATCH, MEM_LEN, D_MODEL), f32)
    norm_w = 1.0 + 0.02 * jax.random.normal(ks[2], (DEPTH, D_MODEL), f32)
    w_in = jax.random.normal(ks[3], (DEPTH, D_MODEL, IN_WIDTH), f32) * D_MODEL ** -0.5
    b_forget = 0.1 * jax.random.normal(ks[4], (DEPTH, FOX_HEADS), f32)
    mem_norm_w = 1.0 + 0.02 * jax.random.normal(ks[5], (DEPTH, D_MODEL), f32)
    w_mem_kv = jax.random.normal(ks[6], (DEPTH, D_MODEL, 2 * MEM_WIDTH), f32) * D_MODEL ** -0.5
    out_norm_w = 1.0 + 0.02 * jax.random.normal(ks[7], (DEPTH, MIX_WIDTH), f32)
    w_out = jax.random.normal(ks[8], (DEPTH, MIX_WIDTH, D_MODEL), f32) * MIX_WIDTH ** -0.5
    final_norm_w = 1.0 + 0.02 * jax.random.normal(ks[9], (D_MODEL,), f32)
    return {"x": x, "mem": mem, "norm_w": norm_w, "w_in": w_in, "b_forget": b_forget,
            "mem_norm_w": mem_norm_w, "w_mem_kv": w_mem_kv, "out_norm_w": out_norm_w,
            "w_out": w_out, "final_norm_w": final_norm_w}


def reference(x, mem, norm_w, w_in, b_forget, mem_norm_w, w_mem_kv, out_norm_w, w_out,
              final_norm_w):
    sizes = [SB_WIDTH] * 3 + [FOX_WIDTH] * 3 + [FOX_HEADS, MEM_WIDTH, MIX_WIDTH]
    offsets = [int(o) for o in np.cumsum(sizes)[:-1]]
    b, s, _ = x.shape
    for layer in range(DEPTH):
        h = rmsnorm(x, norm_w[layer])
        proj = h @ w_in[layer]
        (sb_q, sb_k, sb_v, fx_q, fx_k, fx_v, f_logit, m_q, gate) = jnp.split(proj, offsets, axis=-1)

        sb_out = stick_breaking_attention(split_heads(sb_q, SB_HEADS), split_heads(sb_k, SB_HEADS),
                                          split_heads(sb_v, SB_HEADS))

        log_f = jax.nn.log_sigmoid((f_logit + b_forget[layer]).astype(jnp.float32))
        log_f_cum = jnp.cumsum(log_f.transpose(0, 2, 1), axis=-1)
        fx_out = forgetting_attention(split_heads(fx_q, FOX_HEADS), split_heads(fx_k, FOX_HEADS),
                                      split_heads(fx_v, FOX_HEADS), log_f_cum)

        mem_kv = rmsnorm(mem, mem_norm_w[layer]) @ w_mem_kv[layer]
        m_k, m_v = jnp.split(mem_kv, 2, axis=-1)
        m_out = memory_attention(split_heads(m_q, MEM_HEADS), split_heads(m_k, MEM_HEADS),
                                 split_heads(m_v, MEM_HEADS))

        y = jnp.concatenate([merge_heads(sb_out), merge_heads(fx_out), merge_heads(m_out)], axis=-1)
        yf = y.astype(jnp.float32).reshape(b, s, TOTAL_HEADS, HEAD_DIM)
        yf = yf * lax.rsqrt(jnp.mean(yf * yf, axis=-1, keepdims=True) + EPS)
        yf = yf.reshape(b, s, MIX_WIDTH) * out_norm_w[layer].astype(jnp.float32)
        y = (yf * jax.nn.silu(gate.astype(jnp.float32))).astype(x.dtype)
        x = x + y @ w_out[layer]
    return rmsnorm(x, final_norm_w)
```

```cpp
#include <hip/hip_runtime.h>
#include <cstdio>
#include <cstdint>

namespace {
constexpr int D_MODEL = 1024, BATCH = 8, SEQ = 2048, DEPTH = 2, MEM_LEN = 256, HD = 64;
constexpr int SB_HEADS = 8, FOX_HEADS = 8, MEM_HEADS = 4;
constexpr int MEM_W = 256, MIX_W = 1280, TOTAL_HEADS = 20;
constexpr int IN_W = 4616;
constexpr int OFF_SBQ = 0, OFF_SBK = 512, OFF_SBV = 1024, OFF_FXQ = 1536, OFF_FXK = 2048, OFF_FXV = 2560, OFF_F = 3072, OFF_MQ = 3080, OFF_GATE = 3336;
constexpr float EPS = 1e-6f;

__global__ __launch_bounds__(256) void rmsnorm_k(const float* __restrict__ x, const float* __restrict__ g, float* out) {
    const int row = blockIdx.x, tid = threadIdx.x;
    const float4 v = ((const float4*)(x + (size_t)row * D_MODEL))[tid];
    float s = v.x * v.x + v.y * v.y + v.z * v.z + v.w * v.w;
    for (int o = 32; o > 0; o >>= 1) s += __shfl_xor(s, o);
    __shared__ float red[4];
    if ((tid & 63) == 0) red[tid >> 6] = s;
    __syncthreads();
    const float tot = red[0] + red[1] + red[2] + red[3];
    const float r = rsqrtf(tot * (1.0f / D_MODEL) + EPS);
    const float4 gg = ((const float4*)g)[tid];
    float4 o4; o4.x = v.x * r * gg.x; o4.y = v.y * r * gg.y; o4.z = v.z * r * gg.z; o4.w = v.w * r * gg.w;
    ((float4*)(out + (size_t)row * D_MODEL))[tid] = o4;
}

__global__ __launch_bounds__(256) void gemm_f32(const float* __restrict__ A, int lda, const float* __restrict__ B, int ldb, float* C, int ldc, int M, int N, int K, const float* R, int ldr) {
    __shared__ float As[8][128 + 4];
    __shared__ float Bs[8][128 + 4];
    const int tid = threadIdx.x, tx = tid & 15, ty = tid >> 4;
    const int m0 = blockIdx.y * 128, n0 = blockIdx.x * 128;
    float acc[8][8];
#pragma unroll
    for (int i = 0; i < 8; ++i)
#pragma unroll
        for (int j = 0; j < 8; ++j) acc[i][j] = 0.f;
    for (int k0 = 0; k0 < K; k0 += 8) {
#pragma unroll
        for (int i = 0; i < 4; ++i) { const int idx = tid + i * 256, r = idx >> 3, c = idx & 7; As[c][r] = A[(size_t)(m0 + r) * lda + k0 + c]; }
#pragma unroll
        for (int i = 0; i < 4; ++i) { const int idx = tid + i * 256, r = idx >> 7, c = idx & 127; Bs[r][c] = (n0 + c < N) ? B[(size_t)(k0 + r) * ldb + n0 + c] : 0.f; }
        __syncthreads();
#pragma unroll
        for (int kk = 0; kk < 8; ++kk) {
            float a[8], b[8];
#pragma unroll
            for (int i = 0; i < 8; ++i) a[i] = As[kk][ty * 8 + i];
#pragma unroll
            for (int j = 0; j < 8; ++j) b[j] = Bs[kk][tx * 8 + j];
#pragma unroll
            for (int i = 0; i < 8; ++i)
#pragma unroll
                for (int j = 0; j < 8; ++j) acc[i][j] = fmaf(a[i], b[j], acc[i][j]);
        }
        __syncthreads();
    }
#pragma unroll
    for (int i = 0; i < 8; ++i) {
        const int m = m0 + ty * 8 + i;
#pragma unroll
        for (int j = 0; j < 8; ++j) {
            const int n = n0 + tx * 8 + j;
            if (n < N) { float v = acc[i][j]; if (R) v += R[(size_t)m * ldr + n]; C[(size_t)m * ldc + n] = v; }
        }
    }
}

__device__ __forceinline__ float softplus_f(float z) { return fmaxf(z, 0.f) + log1pf(expf(-fabsf(z))); }

__global__ __launch_bounds__(64) void sb_attn_k(const float* __restrict__ proj, float* y) {
    const int h = blockIdx.y, t = blockIdx.x * 64 + threadIdx.x;
    float q[HD], o[HD];
#pragma unroll
    for (int d = 0; d < HD; ++d) { q[d] = proj[(size_t)t * IN_W + OFF_SBQ + h * HD + d]; o[d] = 0.f; }
    float carry = 0.f;
    for (int s = blockIdx.x * 64 + 62; s >= 0; --s) {
        const float* kp = proj + (size_t)s * IN_W + OFF_SBK + h * HD;
        const float* vp = proj + (size_t)s * IN_W + OFF_SBV + h * HD;
        float z = 0.f;
#pragma unroll
        for (int d = 0; d < HD; ++d) z = fmaf(q[d], kp[d], z);
        z *= 0.125f;
        if (s < t) {
            const float sp = softplus_f(z);
            const float a = expf((z - sp) + carry);
#pragma unroll
            for (int d = 0; d < HD; ++d) o[d] = fmaf(a, vp[d], o[d]);
            carry -= sp;
        }
    }
#pragma unroll
    for (int d = 0; d < HD; ++d) y[(size_t)t * MIX_W + h * HD + d] = o[d];
}

__global__ __launch_bounds__(256) void logf_k(const float* __restrict__ proj, const float* __restrict__ bf, float* c) {
    const int h = blockIdx.x, tid = threadIdx.x;
    __shared__ float tot[256];
    float loc[8]; float run = 0.f;
    const float b = bf[h];
#pragma unroll
    for (int i = 0; i < 8; ++i) { const int t = tid * 8 + i; const float z = proj[(size_t)t * IN_W + OFF_F + h] + b; run += -softplus_f(-z); loc[i] = run; }
    tot[tid] = run;
    __syncthreads();
    float base = 0.f;
    for (int j = 0; j < tid; ++j) base += tot[j];
#pragma unroll
    for (int i = 0; i < 8; ++i) c[(size_t)h * SEQ + tid * 8 + i] = base + loc[i];
}

__global__ __launch_bounds__(64) void fox_attn_k(const float* __restrict__ proj, const float* __restrict__ c, float* y) {
    const int h = blockIdx.y, t = blockIdx.x * 64 + threadIdx.x;
    float q[HD], o[HD];
#pragma unroll
    for (int d = 0; d < HD; ++d) { q[d] = proj[(size_t)t * IN_W + OFF_FXQ + h * HD + d]; o[d] = 0.f; }
    const float ct = c[(size_t)h * SEQ + t];
    float m = -INFINITY, l = 0.f;
    for (int s = 0; s <= blockIdx.x * 64 + 63; ++s) {
        const float* kp = proj + (size_t)s * IN_W + OFF_FXK + h * HD;
        const float* vp = proj + (size_t)s * IN_W + OFF_FXV + h * HD;
        float z = 0.f;
#pragma unroll
        for (int d = 0; d < HD; ++d) z = fmaf(q[d], kp[d], z);
        z = z * 0.125f + (ct - c[(size_t)h * SEQ + s]);
        if (s <= t) {
            const float mn = fmaxf(m, z), al = expf(m - mn), p = expf(z - mn);
            l = l * al + p;
#pragma unroll
            for (int d = 0; d < HD; ++d) o[d] = fmaf(p, vp[d], o[d] * al);
            m = mn;
        }
    }
    const float inv = 1.f / l;
#pragma unroll
    for (int d = 0; d < HD; ++d) y[(size_t)t * MIX_W + 512 + h * HD + d] = o[d] * inv;
}

__global__ __launch_bounds__(64) void mem_attn_k(const float* __restrict__ proj, const float* __restrict__ memkv, float* y) {
    const int h = blockIdx.y, t = blockIdx.x * 64 + threadIdx.x;
    float q[HD], o[HD];
#pragma unroll
    for (int d = 0; d < HD; ++d) { q[d] = proj[(size_t)t * IN_W + OFF_MQ + h * HD + d]; o[d] = 0.f; }
    float m = -INFINITY, l = 0.f;
    for (int s = 0; s < MEM_LEN; ++s) {
        const float* kp = memkv + (size_t)s * (2 * MEM_W) + h * HD;
        const float* vp = memkv + (size_t)s * (2 * MEM_W) + MEM_W + h * HD;
        float z = 0.f;
#pragma unroll
        for (int d = 0; d < HD; ++d) z = fmaf(q[d], kp[d], z);
        z *= 0.125f;
        const float mn = fmaxf(m, z), al = expf(m - mn), p = expf(z - mn);
        l = l * al + p;
#pragma unroll
        for (int d = 0; d < HD; ++d) o[d] = fmaf(p, vp[d], o[d] * al);
        m = mn;
    }
    const float inv = 1.f / l;
#pragma unroll
    for (int d = 0; d < HD; ++d) y[(size_t)t * MIX_W + 1024 + h * HD + d] = o[d] * inv;
}

__global__ __launch_bounds__(64) void post_k(const float* __restrict__ y, const float* __restrict__ proj, const float* __restrict__ onw, float* yg) {
    const int t = blockIdx.x, j = blockIdx.y, d = threadIdx.x;
    const float v = y[(size_t)t * MIX_W + j * HD + d];
    float s = v * v;
    for (int o = 32; o > 0; o >>= 1) s += __shfl_xor(s, o);
    const float r = rsqrtf(s * (1.0f / HD) + EPS);
    const float g = proj[(size_t)t * IN_W + OFF_GATE + j * HD + d];
    const float sg = g / (1.f + expf(-g));
    yg[(size_t)t * MIX_W + j * HD + d] = v * r * onw[j * HD + d] * sg;
}
}

extern "C" void kernel_launch(void* const* d_in, const int* in_sizes, int n_in, void* d_out, int out_size, void* d_ws, size_t ws_size, hipStream_t stream) {
    const float* x = (const float*)d_in[0];
    const float* mem = (const float*)d_in[1];
    const float* norm_w = (const float*)d_in[2];
    const float* w_in = (const float*)d_in[3];
    const float* b_forget = (const float*)d_in[4];
    const float* mem_norm_w = (const float*)d_in[5];
    const float* w_mem_kv = (const float*)d_in[6];
    const float* out_norm_w = (const float*)d_in[7];
    const float* w_out = (const float*)d_in[8];
    const float* final_norm_w = (const float*)d_in[9];
    float* out = (float*)d_out;
    float* ws = (float*)d_ws;
    const size_t MB = (size_t)BATCH * SEQ;
    float* x1 = ws;
    float* hbuf = x1 + MB * D_MODEL;
    float* proj = hbuf + (size_t)SEQ * D_MODEL;
    float* ybuf = proj + (size_t)SEQ * IN_W;
    float* ygbuf = ybuf + (size_t)SEQ * MIX_W;
    float* mh = ygbuf + (size_t)SEQ * MIX_W;
    float* memkv = mh + (size_t)MEM_LEN * D_MODEL;
    float* cbuf = memkv + (size_t)MEM_LEN * 512;
    const size_t need = (size_t)((cbuf + 8 * SEQ) - ws) * 4;
    if (need > ws_size) { fprintf(stderr, "ws too small: need %zu have %zu\n", need, ws_size); return; }
    for (int layer = 0; layer < DEPTH; ++layer) {
        const float* xin = layer == 0 ? x : x1;
        float* xout = layer == 0 ? x1 : out;
        for (int b = 0; b < BATCH; ++b) {
            const float* xb = xin + (size_t)b * SEQ * D_MODEL;
            rmsnorm_k<<<SEQ, 256, 0, stream>>>(xb, norm_w + layer * D_MODEL, hbuf);
            gemm_f32<<<dim3((IN_W + 127) / 128, SEQ / 128), 256, 0, stream>>>(hbuf, D_MODEL, w_in + (size_t)layer * D_MODEL * IN_W, IN_W, proj, IN_W, SEQ, IN_W, D_MODEL, nullptr, 0);
            rmsnorm_k<<<MEM_LEN, 256, 0, stream>>>(mem + (size_t)b * MEM_LEN * D_MODEL, mem_norm_w + layer * D_MODEL, mh);
            gemm_f32<<<dim3(4, 2), 256, 0, stream>>>(mh, D_MODEL, w_mem_kv + (size_t)layer * D_MODEL * 512, 512, memkv, 512, MEM_LEN, 512, D_MODEL, nullptr, 0);
            logf_k<<<FOX_HEADS, 256, 0, stream>>>(proj, b_forget + layer * FOX_HEADS, cbuf);
            sb_attn_k<<<dim3(SEQ / 64, SB_HEADS), 64, 0, stream>>>(proj, ybuf);
            fox_attn_k<<<dim3(SEQ / 64, FOX_HEADS), 64, 0, stream>>>(proj, cbuf, ybuf);
            mem_attn_k<<<dim3(SEQ / 64, MEM_HEADS), 64, 0, stream>>>(proj, memkv, ybuf);
            post_k<<<dim3(SEQ, TOTAL_HEADS), 64, 0, stream>>>(ybuf, proj, out_norm_w + layer * MIX_W, ygbuf);
            gemm_f32<<<dim3(D_MODEL / 128, SEQ / 128), 256, 0, stream>>>(ygbuf, MIX_W, w_out + (size_t)layer * MIX_W * D_MODEL, D_MODEL, xout + (size_t)b * SEQ * D_MODEL, D_MODEL, SEQ, D_MODEL, MIX_W, xb, D_MODEL);
        }
    }
    rmsnorm_k<<<(int)MB, 256, 0, stream>>>(out, final_norm_w, out);
}
```

```cpp
#include <hip/hip_runtime.h>
#include <cstdio>
#include <cstdint>
#include <cmath>

constexpr int D_MODEL = 1024, BATCH = 8, SEQ = 2048, DEPTH = 2, MEM_LEN = 256, HDIM = 64;
constexpr int M_TOK = BATCH * SEQ;
constexpr int M_MEM = BATCH * MEM_LEN;
constexpr int M_CAT = M_TOK + M_MEM;
constexpr int IN_W = 4616, MIX_W = 1280;
constexpr int NPROJ = 4608;
constexpr int NPAD = 4864;
constexpr int PC_SBQ = 0, PC_SBK = 512, PC_SBV = 1024, PC_FXQ = 1536, PC_FXK = 2048, PC_FXV = 2560, PC_MQ = 3072, PC_GATE = 3328;
constexpr float EPS = 1e-6f;
constexpr float LOG2E = 1.4426950408889634f;
constexpr float C2 = 0.125f * LOG2E;
namespace pg8 {
#define PG8_LAS __attribute__((address_space(3)))
typedef unsigned short bf16_t;
typedef short bf16x8 __attribute__((ext_vector_type(8)));
typedef float f32x4 __attribute__((ext_vector_type(4)));
typedef unsigned u32x4 __attribute__((ext_vector_type(4)));
constexpr int BM = 256, BK = 64, HALF = 128, HTB = HALF * BK * 2  , STAGE_BYTES = 8 * HTB, NXCD = 8, WGM = 8;

__host__ __device__ __forceinline__ int lds_byte(int r, int c) { const int st = (r >> 4) * 2 + (c >> 5), rr = r & 15, cc = c & 31, ob = rr * 64 + cc * 2; return st * 1024 + (ob ^ (((ob >> 9) & 1) << 5)); }
__host__ __device__ __forceinline__ void stage_rc(int b, int& R, int& C) { const int st = b / 1024, sb = b % 1024, swz = sb ^ (((sb >> 9) & 1) << 5); R = (st >> 1) * 16 + swz / 64; C = (st & 1) * 32 + (swz % 64) / 2; }
__host__ __device__ __forceinline__ int perm32(int rho) { const int n = rho >> 4, i = rho & 15; return 8 * (i >> 2) + 4 * n + (i & 3); }

struct Unit { int pm, pn; };
struct Gemm { const bf16_t* A; const bf16_t* Bt; int M, N, K; };

struct StaticOrder {
    int nM, nN, nwg, G, c;
    __host__ __device__ void init(int M, int N, int G_, int c_) { nM = M / BM; nN = N / BM; nwg = nM * nN; G = G_; c = c_; }
    __host__ __device__ bool next(int i, Unit& u) const {
        const long L = (long)i * G + c; if (L >= nwg) return false;
        int wgid = (int)L; { const int q = nwg / NXCD, r = nwg % NXCD, xcd = wgid % NXCD, off = wgid / NXCD; wgid = (xcd < r ? xcd * (q + 1) : r * (q + 1) + (xcd - r) * q) + off; }
        const int nig = WGM * nN, gid = wgid / nig, fm = gid * WGM, gsz = (nM - fm) < WGM ? (nM - fm) : WGM;
        u.pm = fm + ((wgid % nig) % gsz); u.pn = (wgid % nig) / gsz; return true;
    }
    __device__ __forceinline__ void a_ready(const Unit&) const {}
    __device__ __forceinline__ void done(const Unit&) const {}
};
__device__ __forceinline__ unsigned cvt_pk_bf16(float lo, float hi) { unsigned r; asm volatile("v_cvt_pk_bf16_f32 %0, %1, %2" : "=v"(r) : "v"(lo), "v"(hi)); return r; }
typedef float f32x2 __attribute__((ext_vector_type(2)));

struct OrderP1 {
    StaticOrder so; int nextra;
    __device__ void init(int G_, int c_, int nextra_) { so.init(M_TOK, NPAD, G_, c_); nextra = nextra_; }
    __device__ bool next(int i, Unit& u) const {
        const long L = (long)i * so.G + so.c;
        if (L < so.nwg) return so.next(i, u);
        const int e = (int)(L - so.nwg); if (e >= nextra) return false;
        u.pm = 64 + (e >> 2); u.pn = 19 + (e & 3); return true;
    }
    __device__ __forceinline__ void a_ready(const Unit&) const {}
    __device__ __forceinline__ void done(const Unit&) const {}
};
__device__ __forceinline__ float row_rstd(const float* stats, int r) {
    const f32x4* sp = (const f32x4*)(stats + (size_t)r * 16);
    const f32x4 a = sp[0], b = sp[1], c = sp[2], d = sp[3];
    const float s = ((a[0] + a[1]) + (a[2] + a[3])) + ((b[0] + b[1]) + (b[2] + b[3])) + ((c[0] + c[1]) + (c[2] + c[3])) + ((d[0] + d[1]) + (d[2] + d[3]));
    return rsqrtf(s * (1.0f / D_MODEL) + EPS);
}
__device__ __forceinline__ float log_sigmoid_f(float f) { return fminf(f, 0.f) - log1pf(expf(-fabsf(f))); }
struct EpiP1 {
    static constexpr bool PERM = true, AFTER_DRAIN = false;
    bf16_t* proj; bf16_t* memkv; float* lgf; const float* stats; const float* bforget;
    __device__ __forceinline__ void operator()(const f32x4 (&acc)[2][2][4][2], const Unit& u, int wr, int wc, int fr, int fq) const {
        const int row0 = u.pm * BM + wr * 64 + fr;
        float rs[2][4];
#pragma unroll
        for (int ai = 0; ai < 2; ++ai)
#pragma unroll
            for (int m = 0; m < 4; ++m) rs[ai][m] = row_rstd(stats, row0 + ai * HALF + m * 16);
        if (u.pm < 64 && u.pn == 18) {
            if (wc == 0 && fq == 0) {
                float bf[8];
#pragma unroll
                for (int j = 0; j < 8; ++j) bf[j] = bforget[j];
#pragma unroll
                for (int ai = 0; ai < 2; ++ai)
#pragma unroll
                    for (int m = 0; m < 4; ++m) { const int r = row0 + ai * HALF + m * 16, b = r >> 11, s = r & 2047; float* lp = lgf + (size_t)b * 8 * SEQ + s;
#pragma unroll
                        for (int j = 0; j < 4; ++j) { lp[(size_t)j * SEQ] = log_sigmoid_f(acc[ai][0][m][0][j] * rs[ai][m] + bf[j]); lp[(size_t)(4 + j) * SEQ] = log_sigmoid_f(acc[ai][0][m][1][j] * rs[ai][m] + bf[4 + j]); } }
            }
            return;
        }
        bf16_t* base; size_t pitch; float sc = 1.f; int colt;
        if (u.pm < 64) { base = proj + (size_t)row0 * NPROJ; pitch = NPROJ; colt = u.pn * BM; if (u.pn < 2 || u.pn == 6 || u.pn == 7 || u.pn == 12) sc = C2; }
        else { const int t = u.pn - 19; base = memkv + (size_t)(t >> 1) * M_MEM * 512 + (size_t)(row0 - M_TOK) * 512; pitch = 512; colt = (t & 1) * BM; }
        const int col0 = colt + wc * 32 + 8 * fq;
#pragma unroll
        for (int ai = 0; ai < 2; ++ai)
#pragma unroll
            for (int m = 0; m < 4; ++m) { bf16_t* rowp = base + (size_t)(ai * HALF + m * 16) * pitch + col0; const float s = rs[ai][m] * sc;
#pragma unroll
                for (int bj = 0; bj < 2; ++bj) { const f32x4 v0 = acc[ai][bj][m][0] * s, v1 = acc[ai][bj][m][1] * s;
                    u32x4 w; w.x = cvt_pk_bf16(v0[0], v0[1]); w.y = cvt_pk_bf16(v0[2], v0[3]); w.z = cvt_pk_bf16(v1[0], v1[1]); w.w = cvt_pk_bf16(v1[2], v1[3]);
                    *(u32x4*)(rowp + bj * HALF) = w; } }
    }
};
struct EpiP3 {
    static constexpr bool PERM = true, AFTER_DRAIN = false;
    const float* xin; float* xout; bf16_t* xb; float* stats;
    __device__ __forceinline__ void operator()(const f32x4 (&acc)[2][2][4][2], const Unit& u, int wr, int wc, int fr, int fq) const {
        const int row0 = u.pm * BM + wr * 64 + fr, col0 = u.pn * BM + wc * 32 + 8 * fq;
#pragma unroll
        for (int ai = 0; ai < 2; ++ai)
#pragma unroll
            for (int m = 0; m < 4; ++m) { const int r = row0 + ai * HALF + m * 16; float ss = 0.f;
#pragma unroll
                for (int bj = 0; bj < 2; ++bj) { const size_t off = (size_t)r * D_MODEL + col0 + bj * HALF;
                    const f32x4 x0 = *(const f32x4*)(xin + off), x1 = *(const f32x4*)(xin + off + 4);
                    const f32x4 v0 = acc[ai][bj][m][0] + x0, v1 = acc[ai][bj][m][1] + x1;
                    *(f32x4*)(xout + off) = v0; *(f32x4*)(xout + off + 4) = v1;
                    ss += (v0[0] * v0[0] + v0[1] * v0[1]) + (v0[2] * v0[2] + v0[3] * v0[3]) + (v1[0] * v1[0] + v1[1] * v1[1]) + (v1[2] * v1[2] + v1[3] * v1[3]);
                    u32x4 w; w.x = cvt_pk_bf16(v0[0], v0[1]); w.y = cvt_pk_bf16(v0[2], v0[3]); w.z = cvt_pk_bf16(v1[0], v1[1]); w.w = cvt_pk_bf16(v1[2], v1[3]);
                    *(u32x4*)(xb + off) = w; }
                ss += __shfl_xor(ss, 16); ss += __shfl_xor(ss, 32);
                if (fq == 0) stats[(size_t)r * 16 + u.pn * 4 + wc] = ss; }
    }
};

template <class Epi, class Sched, bool ALIGN_EPI = false, bool SP2 = false>
__device__ __forceinline__ void gemm_phase(PG8_LAS unsigned char* lds, const Gemm g, const Sched& S, const Epi& E) {
    int tid_ = threadIdx.x; asm volatile("" : "+v"(tid_));
    const int tid = tid_, wid = __builtin_amdgcn_readfirstlane(tid >> 6), lane = tid & 63, wr = wid >> 2, wc = wid & 3, fr = lane & 15, fq = lane >> 4;
    const int K = g.K, nt = K / BK;
    unsigned voffA[2], voffB[2];
#pragma unroll
    for (int i = 0; i < 2; ++i) { int R, C; stage_rc(tid * 16 + i * 8192, R, C); const int Rb = Epi::PERM ? ((R & ~31) + perm32(R & 31)) : R;
        voffA[i] = (unsigned)(R * K + C) * 2u; voffB[i] = (unsigned)(Rb * K + C) * 2u; }
    const size_t kstep = (size_t)(BK * 2);
    const size_t hstep = (size_t)HALF * K * 2;
    const size_t tstep = 2 * hstep;
    const unsigned ldsw = (unsigned)wid * 1024u;
    const int aoff = lds_byte(wr * 64 + fr, fq * 8), boff = lds_byte(wc * 32 + fr, fq * 8);
#define PG8_SA(b, h) (((b) * 2 + (h)) * HTB)
#define PG8_SB(b, h) ((4 + (b) * 2 + (h)) * HTB)
#define PG8_STAGE(bufoff, gbase, voff) do { _Pragma("unroll") for (int _i = 0; _i < 2; ++_i) \
        __builtin_amdgcn_global_load_lds((const unsigned*)((const char*)(gbase) + (voff)[_i]), (PG8_LAS unsigned*)(lds + (bufoff) + ldsw + _i * 8192), 16, 0, 0); } while (0)
#define PG8_LDA(dst, b, h) do { _Pragma("unroll") for (int m = 0; m < 4; ++m) _Pragma("unroll") for (int k = 0; k < 2; ++k) dst[m][k] = *(const PG8_LAS bf16x8*)(lds + PG8_SA(b, h) + aoff + m * 2048 + k * 1024); } while (0)
#define PG8_LDB(dst, b, h) do { _Pragma("unroll") for (int n = 0; n < 2; ++n) _Pragma("unroll") for (int k = 0; k < 2; ++k) dst[n][k] = *(const PG8_LAS bf16x8*)(lds + PG8_SB(b, h) + boff + n * 2048 + k * 1024); } while (0)
#define PG8_MMA(ai, bj, At, Bt) do { __builtin_amdgcn_s_setprio(1); _Pragma("unroll") for (int m = 0; m < 4; ++m) _Pragma("unroll") for (int n = 0; n < 2; ++n) _Pragma("unroll") for (int k = 0; k < 2; ++k) \
        acc[ai][bj][m][n] = __builtin_amdgcn_mfma_f32_16x16x32_bf16(Bt[n][k], At[m][k], acc[ai][bj][m][n], 0, 0, 0); __builtin_amdgcn_s_setprio(0); } while (0)
#define PG8_WAIT_V(n) asm volatile("s_waitcnt vmcnt(" #n ")" ::: "memory")
#define PG8_WAIT_L(n) asm volatile("s_waitcnt lgkmcnt(" #n ")" ::: "memory")
#define PG8_BAR __builtin_amdgcn_s_barrier()
#define PG8_SCHED __builtin_amdgcn_sched_barrier(0)
    Unit cur, nxt; int ui = 0;
    if (!S.next(0, cur)) return;
    f32x4 acc[2][2][4][2];
#pragma unroll
    for (int a = 0; a < 2; ++a)
#pragma unroll
        for (int b = 0; b < 2; ++b)
#pragma unroll
            for (int m = 0; m < 4; ++m)
#pragma unroll
                for (int n = 0; n < 2; ++n) acc[a][b][m][n] = (f32x4){0.f, 0.f, 0.f, 0.f};
    bf16x8 At[4][2], B0[2][2], B1[2][2];
    const char* cA = (const char*)g.A + (size_t)cur.pm * tstep; const char* cB = (const char*)g.Bt + (size_t)cur.pn * tstep;
    S.a_ready(cur);
    if constexpr (SP2) {
        PG8_STAGE(PG8_SB(0, 0), cB, voffB); PG8_STAGE(PG8_SB(0, 1), cB + hstep, voffB); PG8_STAGE(PG8_SA(0, 0), cA, voffA); PG8_STAGE(PG8_SA(0, 1), cA + hstep, voffA);
        if (wr == 1) PG8_BAR;
        PG8_WAIT_V(2); PG8_BAR;
        PG8_STAGE(PG8_SB(1, 0), cB + kstep, voffB); PG8_STAGE(PG8_SA(1, 0), cA + kstep, voffA); PG8_STAGE(PG8_SB(1, 1), cB + hstep + kstep, voffB);
        PG8_WAIT_V(6); PG8_BAR;
    } else {
        PG8_STAGE(PG8_SB(0, 0), cB, voffB); PG8_STAGE(PG8_SA(0, 0), cA, voffA); PG8_STAGE(PG8_SB(0, 1), cB + hstep, voffB); PG8_STAGE(PG8_SA(0, 1), cA + hstep, voffA);
        if (wr == 1) PG8_BAR;
        PG8_WAIT_V(4); PG8_BAR;
        PG8_STAGE(PG8_SB(1, 0), cB + kstep, voffB); PG8_STAGE(PG8_SA(1, 0), cA + kstep, voffA); PG8_STAGE(PG8_SB(1, 1), cB + hstep + kstep, voffB);
        PG8_WAIT_V(6); PG8_BAR;
    }
    for (;;) {
        const bool has_next = S.next(ui + 1, nxt);
        const char* nA = has_next ? (const char*)g.A + (size_t)nxt.pm * tstep : cA; const char* nB = has_next ? (const char*)g.Bt + (size_t)nxt.pn * tstep : cB;
        for (int t = 0; t < nt; t += 2) {
            const bool last = (t == nt - 2);
            const char* a1 = cA + (size_t)(t + 1) * kstep;
            const char* a2 = last ? nA : cA + (size_t)(t + 2) * kstep; const char* b2 = last ? nB : cB + (size_t)(t + 2) * kstep;
            const char* a3 = a2 + kstep; const char* b3 = b2 + kstep;
            if (last && has_next) S.a_ready(nxt);
            if constexpr (SP2) {
            PG8_LDB(B0, 0, 0); PG8_LDB(B1, 0, 1); PG8_SCHED; PG8_LDA(At, 0, 0); PG8_STAGE(PG8_SA(1, 1), a1 + hstep, voffA);
            PG8_WAIT_V(8); PG8_WAIT_L(0); PG8_BAR; PG8_MMA(0, 0, At, B0); PG8_MMA(0, 1, At, B1); PG8_BAR; PG8_SCHED;
            PG8_LDA(At, 0, 1); PG8_STAGE(PG8_SB(0, 0), b2, voffB); PG8_STAGE(PG8_SB(0, 1), b2 + hstep, voffB); PG8_STAGE(PG8_SA(0, 0), a2, voffA);
            PG8_WAIT_V(8); PG8_WAIT_L(0); PG8_BAR; PG8_MMA(1, 0, At, B0); PG8_MMA(1, 1, At, B1); PG8_BAR; PG8_SCHED;
            PG8_LDB(B0, 1, 0); PG8_LDB(B1, 1, 1); PG8_SCHED; PG8_LDA(At, 1, 0); PG8_STAGE(PG8_SA(0, 1), a2 + hstep, voffA);
            PG8_WAIT_V(8); PG8_WAIT_L(0); PG8_BAR; PG8_MMA(0, 0, At, B0); PG8_MMA(0, 1, At, B1); PG8_BAR; PG8_SCHED;
            PG8_LDA(At, 1, 1); PG8_STAGE(PG8_SB(1, 0), b3, voffB); PG8_STAGE(PG8_SB(1, 1), b3 + hstep, voffB); PG8_STAGE(PG8_SA(1, 0), a3, voffA);
            PG8_WAIT_V(8); PG8_WAIT_L(0); PG8_BAR; PG8_MMA(1, 0, At, B0); PG8_MMA(1, 1, At, B1); PG8_BAR; PG8_SCHED;
            } else {
            PG8_LDB(B0, 0, 0); PG8_SCHED; PG8_LDA(At, 0, 0); PG8_STAGE(PG8_SA(1, 1), a1 + hstep, voffA);
            PG8_WAIT_L(8); PG8_BAR; PG8_WAIT_L(0); PG8_MMA(0, 0, At, B0); PG8_BAR; PG8_SCHED;
            PG8_LDB(B1, 0, 1); PG8_STAGE(PG8_SB(0, 0), b2, voffB);
            PG8_BAR; PG8_WAIT_L(0); PG8_MMA(0, 1, At, B1); PG8_BAR;
            PG8_LDA(At, 0, 1); PG8_STAGE(PG8_SA(0, 0), a2, voffA);
            PG8_BAR; PG8_WAIT_L(0); PG8_MMA(1, 0, At, B0); PG8_BAR; PG8_SCHED;
            PG8_STAGE(PG8_SB(0, 1), b2 + hstep, voffB);
            PG8_WAIT_V(6); PG8_BAR; PG8_MMA(1, 1, At, B1); PG8_BAR;
            PG8_LDB(B0, 1, 0); PG8_SCHED; PG8_LDA(At, 1, 0); PG8_STAGE(PG8_SA(0, 1), a2 + hstep, voffA);
            PG8_WAIT_L(8); PG8_BAR; PG8_WAIT_L(0); PG8_MMA(0, 0, At, B0); PG8_BAR; PG8_SCHED;
            PG8_LDB(B1, 1, 1); PG8_STAGE(PG8_SB(1, 0), b3, voffB);
            PG8_BAR; PG8_WAIT_L(0); PG8_MMA(0, 1, At, B1); PG8_BAR;
            PG8_LDA(At, 1, 1); PG8_STAGE(PG8_SA(1, 0), a3, voffA);
            PG8_BAR; PG8_WAIT_L(0); PG8_MMA(1, 0, At, B0); PG8_BAR; PG8_SCHED;
            PG8_STAGE(PG8_SB(1, 1), b3 + hstep, voffB);
            PG8_WAIT_V(6); PG8_BAR; PG8_MMA(1, 1, At, B1); PG8_BAR;
            }
        }
        if constexpr (ALIGN_EPI) { if (wr == 0) PG8_BAR; }
        if constexpr (!Epi::AFTER_DRAIN) { E(acc, cur, wr, wc, fr, fq); S.done(cur); }
        if (!has_next) break;
#pragma unroll
        for (int a = 0; a < 2; ++a)
#pragma unroll
            for (int b = 0; b < 2; ++b)
#pragma unroll
                for (int m = 0; m < 4; ++m)
#pragma unroll
                    for (int n = 0; n < 2; ++n) acc[a][b][m][n] = (f32x4){0.f, 0.f, 0.f, 0.f};
        cur = nxt; cA = nA; cB = nB; ++ui;
        if constexpr (ALIGN_EPI) { if (wr == 1) PG8_BAR; }
    }
    PG8_WAIT_V(0);
    if constexpr (!ALIGN_EPI) { if (wr == 0) PG8_BAR; }
    PG8_BAR;
    if constexpr (Epi::AFTER_DRAIN) { E.fused(acc, cur, wr, wc, fr, fq, lds, wid, lane); S.done(cur); }
#undef PG8_SA
#undef PG8_SB
#undef PG8_STAGE
#undef PG8_LDA
#undef PG8_LDB
#undef PG8_MMA
#undef PG8_WAIT_V
#undef PG8_WAIT_L
#undef PG8_BAR
#undef PG8_SCHED
}
}
#define GAS __attribute__((address_space(1)))
#define LAS __attribute__((address_space(3)))
typedef unsigned short bf16;
typedef unsigned v4u __attribute__((ext_vector_type(4)));
typedef float f32x4 __attribute__((ext_vector_type(4)));
typedef short bf16x8 __attribute__((ext_vector_type(8)));
typedef GAS unsigned gu32;
typedef GAS unsigned long long gu64;
#define RLX_AGENT __ATOMIC_RELAXED, __HIP_MEMORY_SCOPE_AGENT
#define LDS_WAIT() asm volatile("s_waitcnt lgkmcnt(0)" ::: "memory")
#define VM_WAIT() asm volatile("s_waitcnt vmcnt(0)" ::: "memory")
__device__ __forceinline__ unsigned long long rt() { return __builtin_amdgcn_s_memrealtime(); }
__device__ __forceinline__ unsigned f2bf(float f) { unsigned u = __builtin_bit_cast(unsigned, f); return (u + 0x7fffu + ((u >> 16) & 1u)) >> 16; }
__device__ __forceinline__ unsigned pk2(float lo, float hi) { return f2bf(lo) | (f2bf(hi) << 16); }

#define XB_TMO      128
#define XB_XCNT(j)  (256  + 64 * (j))
#define XB_XSUB(j)  (1280 + 64 * (j))
#define XB_XGEN(j)  (2304 + 64 * (j))
#define XB_TOP      3328
#define XB_TOPGEN   3392
#define XCD_BAR_WORDS 3456
#define XB_SPIN_CAP (1u << 18)

__device__ __forceinline__ unsigned xb_ld(unsigned* p)              { return __hip_atomic_load(p, __ATOMIC_RELAXED, __HIP_MEMORY_SCOPE_AGENT); }
__device__ __forceinline__ unsigned xb_add(unsigned* p, unsigned v) { return __hip_atomic_fetch_add(p, v, __ATOMIC_RELAXED, __HIP_MEMORY_SCOPE_AGENT); }
__device__ __forceinline__ unsigned xb_xcc_id() { return (unsigned)__builtin_amdgcn_s_getreg((3 << 11) | 20) & 0xFu; }
#define XB_SPIN(cond, bar) do { unsigned _sp = 0; while (cond) { __builtin_amdgcn_s_sleep(1); \
    if ((++_sp & 255u) == 0u) { if (xb_ld(&(bar)[XB_TMO])) break; if (_sp > XB_SPIN_CAP) { atomicAdd(&(bar)[XB_TMO], 1u); break; } } } } while (0)

struct XcdBarrier {
    unsigned* bar; unsigned x;
    volatile LAS unsigned* st;
};

__device__ __forceinline__ XcdBarrier xcd_barrier_post(unsigned* bar, volatile LAS unsigned* st) {
    XcdBarrier b; b.bar = bar; b.x = xb_xcc_id(); b.st = st;
    if (threadIdx.x == 0) (void)xb_add(&bar[XB_XCNT(b.x)], 1u);
    return b;
}
__device__ __forceinline__ void xcd_barrier_complete(unsigned* bar, unsigned x, unsigned& nloc, unsigned& nx) {
    const unsigned G = gridDim.x * gridDim.y * gridDim.z;
    unsigned sum, cnt, mine, sp = 0u;
    for (;;) {
        sum = 0u; cnt = 0u; mine = 0u;
#pragma unroll
        for (unsigned j = 0; j < 16; ++j) { const unsigned c = xb_ld(&bar[XB_XCNT(j)]); sum += c; cnt += (c > 0u) ? 1u : 0u; mine = (j == x) ? c : mine; }
        if (sum == G) break;
        __builtin_amdgcn_s_sleep(1);
        if ((++sp & 255u) == 0u) { if (xb_ld(&bar[XB_TMO])) break; if (sp > XB_SPIN_CAP) { atomicAdd(&bar[XB_TMO], 1u); break; } }
    }
    nloc = mine > 0u ? mine : 1u; nx = cnt > 0u ? cnt : 1u;
}

__device__ __forceinline__ void xcd_barrier(const XcdBarrier& b) {
    asm volatile("s_waitcnt vmcnt(0)" ::: "memory");
    __syncthreads();
    if (threadIdx.x == 0) {
        unsigned* bar = b.bar;
        __builtin_amdgcn_s_waitcnt(0);
        unsigned nloc = b.st[0], nx = b.st[1];
        if (nloc == 0u) { xcd_barrier_complete(bar, b.x, nloc, nx); b.st[0] = nloc; b.st[1] = nx; }
        const unsigned old = xb_add(&bar[XB_XSUB(b.x)], 1u);
        const unsigned gen = old / nloc;
        if (old + 1u == (gen + 1u) * nloc) {
            __builtin_amdgcn_fence(__ATOMIC_RELEASE, "agent");
            asm volatile("s_waitcnt vmcnt(0)" ::: "memory");
            const unsigned og = xb_add(&bar[XB_TOP], 1u);
            const unsigned tg = og / nx;
            if (og + 1u == (tg + 1u) * nx) xb_add(&bar[XB_TOPGEN], 1u);
            else XB_SPIN(xb_ld(&bar[XB_TOPGEN]) == tg, bar);
            __builtin_amdgcn_fence(__ATOMIC_ACQUIRE, "agent");
            xb_add(&bar[XB_XGEN(b.x)], 1u);
            asm volatile("s_waitcnt vmcnt(0)" ::: "memory");
        } else {
            XB_SPIN(xb_ld(&bar[XB_XGEN(b.x)]) == gen, bar);
            __builtin_amdgcn_fence(__ATOMIC_ACQUIRE, "agent");
            asm volatile("s_waitcnt vmcnt(0)" ::: "memory");
        }
    }
    __syncthreads();
}
namespace att {
typedef short bf16x8 __attribute__((ext_vector_type(8)));
typedef _Float16 f16x8 __attribute__((ext_vector_type(8)));
typedef _Float16 f16x2 __attribute__((ext_vector_type(2)));
typedef short s16x4 __attribute__((ext_vector_type(4)));
typedef float f32x16 __attribute__((ext_vector_type(16)));
typedef float f32x4 __attribute__((ext_vector_type(4)));
typedef float f32x2_t __attribute__((ext_vector_type(2)));
typedef __bf16 bf16x2_t __attribute__((ext_vector_type(2)));
typedef unsigned u32x4 __attribute__((ext_vector_type(4)));
typedef unsigned short bf16;
#define ALAS __attribute__((address_space(3)))
constexpr int SLOTB = 8192;
constexpr int L_K = 0, L_V = 2 * SLOTB, L_WS = 4 * SLOTB, L_OST = L_WS + 2048, OSTW = 32 * 68 * 4, L_CB = L_OST + 8 * OSTW, L_SC = L_CB + SEQ * 4, L_END = L_SC + 256;
constexpr float THR = 8.f;
__device__ __forceinline__ int crow(int r, int hi) { return (r & 3) + 8 * (r >> 2) + 4 * hi; }
__device__ __forceinline__ void glds16(const void* gsrc, unsigned lds_dst) { unsigned keep;
    asm volatile("s_mov_b32 %0, m0\n\ts_mov_b32 m0, %2\n\ts_nop 0\n\tglobal_load_lds_dwordx4 %1, off\n\ts_mov_b32 m0, %0" : "=&s"(keep) : "v"(gsrc), "s"(lds_dst) : "memory"); }
__device__ __forceinline__ unsigned cvtpk_s(float lo, float hi) { f32x2_t v = {lo, hi}; bf16x2_t b = __builtin_convertvector(v, bf16x2_t); return __builtin_bit_cast(unsigned, b); }
__device__ __forceinline__ unsigned cvtpk_h(float lo, float hi) { f32x2_t v = {lo, hi}; f16x2 b = __builtin_convertvector(v, f16x2); return __builtin_bit_cast(unsigned, b); }
__device__ __forceinline__ float bf2f(unsigned short x) { return __uint_as_float((unsigned)x << 16); }
#define AWAIT_BAR(N) asm volatile("s_waitcnt vmcnt(" #N ") lgkmcnt(0)\n\ts_barrier" ::: "memory")
__device__ __forceinline__ void qkt(f32x16& p0, f32x16& p1, const ALAS char* kb, const bf16x8* qr) {
    const f32x16 z = {};
#pragma unroll
    for (int d0 = 0; d0 < 4; ++d0) {
        const bf16x8 b0 = *(const ALAS bf16x8*)(kb + d0 * 2048);
        const bf16x8 b1 = *(const ALAS bf16x8*)(kb + d0 * 2048 + 512);
        if (d0 == 0) { p0 = __builtin_amdgcn_mfma_f32_32x32x16_bf16(b0, qr[0], z, 0, 0, 0); p1 = __builtin_amdgcn_mfma_f32_32x32x16_bf16(b1, qr[0], z, 0, 0, 0); }
        else { p0 = __builtin_amdgcn_mfma_f32_32x32x16_bf16(b0, qr[d0], p0, 0, 0, 0); p1 = __builtin_amdgcn_mfma_f32_32x32x16_bf16(b1, qr[d0], p1, 0, 0, 0); } }
}
__device__ __forceinline__ void pv(f32x16* o, int vb, bf16x8 pa0, bf16x8 pa1, bf16x8 pa2, bf16x8 pa3) {
#pragma unroll
    for (int d0 = 0; d0 < 2; ++d0) { s16x4 lo[4], hi[4];
#pragma unroll
        for (int ks = 0; ks < 4; ++ks) {
            asm volatile("ds_read_b64_tr_b16 %0,%1 offset:%c2" : "=&v"(lo[ks]) : "v"(vb), "i"(d0 * 4096 + ks * 1024) : "memory");
            asm volatile("ds_read_b64_tr_b16 %0,%1 offset:%c2" : "=&v"(hi[ks]) : "v"(vb), "i"(d0 * 4096 + ks * 1024 + 512) : "memory"); }
        asm volatile("s_waitcnt lgkmcnt(0)" ::: "memory"); __builtin_amdgcn_sched_barrier(0);
#define ATT_PK(k) (bf16x8){lo[k][0], lo[k][1], lo[k][2], lo[k][3], hi[k][0], hi[k][1], hi[k][2], hi[k][3]}
        o[d0] = __builtin_amdgcn_mfma_f32_32x32x16_bf16(pa0, ATT_PK(0), o[d0], 0, 0, 0);
        o[d0] = __builtin_amdgcn_mfma_f32_32x32x16_bf16(pa1, ATT_PK(1), o[d0], 0, 0, 0);
        o[d0] = __builtin_amdgcn_mfma_f32_32x32x16_bf16(pa2, ATT_PK(2), o[d0], 0, 0, 0);
        o[d0] = __builtin_amdgcn_mfma_f32_32x32x16_bf16(pa3, ATT_PK(3), o[d0], 0, 0, 0);
#undef ATT_PK
    }
}
__device__ __forceinline__ float rowmax(const f32x16& p0, const f32x16& p1) {
    float a = fmaxf(p0[0], p1[0]);
#pragma unroll
    for (int r = 1; r < 16; ++r) a = fmaxf(a, fmaxf(p0[r], p1[r]));
    auto rr = __builtin_amdgcn_permlane32_swap(__float_as_uint(a), __float_as_uint(a), false, false);
    return fmaxf(__uint_as_float(rr[0]), __uint_as_float(rr[1]));
}
struct Args { const bf16* proj; const bf16* memkv; const float* logf; const float* onw; bf16* y; };

template <int MODE>
__device__ __forceinline__ void attn_unit(const Args& A, int b, int h, int qb, ALAS char* lds) {
    constexpr int KVP = (MODE == 2) ? 512 : NPROJ;
    constexpr int QCOL = MODE == 0 ? PC_SBQ : (MODE == 1 ? PC_FXQ : PC_MQ);
    constexpr int HG0 = MODE == 0 ? 0 : (MODE == 1 ? 8 : 16);
    int tid_ = threadIdx.x; asm volatile("" : "+v"(tid_));
    const int tid = tid_, lane = tid & 63, r32 = lane & 31, hi = lane >> 5; const int wid = __builtin_amdgcn_readfirstlane(tid >> 6);
    const int q0 = qb * 256;
    const size_t trow0 = (size_t)b * SEQ + q0 + wid * 32;
    const bf16* Qw = A.proj + trow0 * NPROJ + QCOL + h * HDIM;
    const bf16* Kh = (MODE == 2) ? A.memkv + (size_t)b * MEM_LEN * 512 + h * HDIM : A.proj + (size_t)b * SEQ * NPROJ + (MODE == 0 ? PC_SBK : PC_FXK) + h * HDIM;
    const bf16* Vh = (MODE == 2) ? A.memkv + (size_t)b * MEM_LEN * 512 + 256 + h * HDIM : A.proj + (size_t)b * SEQ * NPROJ + (MODE == 0 ? PC_SBV : PC_FXV) + h * HDIM;
    const unsigned lds0 = (unsigned)(uintptr_t)lds;
    ALAS float* wsf = (ALAS float*)(lds + L_WS) + wid * 64;
    const int NT = (MODE == 2) ? 4 : 4 * qb + 4;
    if (MODE == 1) {
        ALAS float* cb = (ALAS float*)(lds + L_CB); ALAS float* sc = (ALAS float*)(lds + L_SC);
        const int n = 256 * (qb + 1); const float* lf = A.logf + (size_t)(b * 8 + h) * SEQ;
        f32x4 v = {0.f, 0.f, 0.f, 0.f}; if (4 * tid < n) v = *(const f32x4*)(lf + 4 * tid);
        const float a0 = v[0], a1 = a0 + v[1], a2 = a1 + v[2], a3 = a2 + v[3];
        float x = a3;
#pragma unroll
        for (int o = 1; o < 64; o <<= 1) { const float yv = __shfl_up(x, o); if (lane >= o) x += yv; }
        if (lane == 63) sc[wid] = x;
        asm volatile("s_waitcnt lgkmcnt(0)\n\ts_barrier" ::: "memory");
        float off = 0.f, tot = 0.f;
#pragma unroll
        for (int w = 0; w < 8; ++w) { const float sw = sc[w]; if (w < wid) off += sw; if (w < (n >> 8)) tot += sw; }
        const float ex = off + x - a3;
        if (4 * tid < n) { f32x4 cbv; cbv[0] = (tot - (ex + a0)) * LOG2E; cbv[1] = (tot - (ex + a1)) * LOG2E; cbv[2] = (tot - (ex + a2)) * LOG2E; cbv[3] = (tot - (ex + a3)) * LOG2E; *(ALAS f32x4*)(cb + 4 * tid) = cbv; }
    }
    const bf16* ksrc = Kh + (size_t)lane * KVP + wid * 8;
    const bf16* vsrc = Vh + (size_t)(16 * (wid & 3) + (lane >> 2)) * KVP + (wid >> 2) * 32 + (lane & 3) * 8;
    const unsigned kdst = lds0 + L_K + wid * 1024, vdst = lds0 + L_V + wid * 1024;
#define DMA_K(t, slot) glds16(ksrc + (size_t)(t) * 64 * KVP, (unsigned)__builtin_amdgcn_readfirstlane(kdst + (slot)))
#define DMA_V(t, slot) glds16(vsrc + (size_t)(t) * 64 * KVP, (unsigned)__builtin_amdgcn_readfirstlane(vdst + (slot)))
    DMA_K(NT - 1, 0); DMA_V(NT - 1, 0);
    bf16x8 qr[4];
#pragma unroll
    for (int d0 = 0; d0 < 4; ++d0) qr[d0] = *(const bf16x8*)(Qw + (size_t)r32 * NPROJ + d0 * 16 + hi * 8);
    const int vb0 = (int)(lds0 + L_V) + ((lane >> 4) & 1) * 32 + (lane & 3) * 8 + (4 * hi + ((lane & 15) >> 2)) * 64;
    const ALAS char* kp0 = lds + L_K + hi * 1024 + r32 * 16;
    f32x16 o[2]; o[0] = f32x16{}; o[1] = f32x16{};
    float mhat = -1e30f, l_reg = 0.f, carry = 0.f;
    const int qrel = wid * 32 + r32;
    f16x8 T0, T1, ONES;
    if (MODE == 0) {
#pragma unroll
        for (int j = 0; j < 8; ++j) { const int m0 = 8 * (j >> 2) + 4 * hi + (j & 3); T0[j] = (m0 >= r32) ? (_Float16)1.0f : (_Float16)0.0f; T1[j] = (16 + m0 >= r32) ? (_Float16)1.0f : (_Float16)0.0f; ONES[j] = (_Float16)1.0f; }
    }
    for (int i = 0; i < NT; ++i) {
        const int t = NT - 1 - i; const int slot = (i & 1) * SLOTB;
        AWAIT_BAR(0);
        if (i + 1 < NT) { DMA_K(t - 1, slot ^ SLOTB); DMA_V(t - 1, slot ^ SLOTB); }
        const int jb = (MODE == 2) ? -1 : t - 4 * qb;
        if (jb > (wid >> 1)) continue;
        f32x16 p0, p1;
        qkt(p0, p1, kp0 + slot, qr);
        if (MODE == 1) {
            const ALAS float* cbt = (const ALAS float*)(lds + L_CB) + 64 * t + 4 * hi;
#pragma unroll
            for (int g = 0; g < 4; ++g) { const f32x4 b0 = *(const ALAS f32x4*)(cbt + 8 * g), b1 = *(const ALAS f32x4*)(cbt + 32 + 8 * g);
#pragma unroll
                for (int e = 0; e < 4; ++e) { p0[4 * g + e] += b0[e]; p1[4 * g + e] += b1[e]; } }
        }
        if (MODE != 2 && jb >= 0) {
            const int kb = 64 * jb + 4 * hi, lim = (MODE == 0) ? qrel - 1 : qrel;
#pragma unroll
            for (int r = 0; r < 16; ++r) { const int kv = kb + (r & 3) + 8 * (r >> 2); if (kv > lim) p0[r] = -INFINITY; if (kv + 32 > lim) p1[r] = -INFINITY; }
        }
        if (MODE == 0) {
            f32x16 l0, l1;
#pragma unroll
            for (int r = 0; r < 16; ++r) { l0[r] = __builtin_amdgcn_logf(1.0f + __builtin_amdgcn_exp2f(p0[r])); l1[r] = __builtin_amdgcn_logf(1.0f + __builtin_amdgcn_exp2f(p1[r])); }
            u32x4 w0, w1, w2, w3;
            w0 = (u32x4){cvtpk_h(l0[0], l0[1]), cvtpk_h(l0[2], l0[3]), cvtpk_h(l0[4], l0[5]), cvtpk_h(l0[6], l0[7])};
            w1 = (u32x4){cvtpk_h(l0[8], l0[9]), cvtpk_h(l0[10], l0[11]), cvtpk_h(l0[12], l0[13]), cvtpk_h(l0[14], l0[15])};
            w2 = (u32x4){cvtpk_h(l1[0], l1[1]), cvtpk_h(l1[2], l1[3]), cvtpk_h(l1[4], l1[5]), cvtpk_h(l1[6], l1[7])};
            w3 = (u32x4){cvtpk_h(l1[8], l1[9]), cvtpk_h(l1[10], l1[11]), cvtpk_h(l1[12], l1[13]), cvtpk_h(l1[14], l1[15])};
            const f16x8 f0 = __builtin_bit_cast(f16x8, w0), f1 = __builtin_bit_cast(f16x8, w1), f2 = __builtin_bit_cast(f16x8, w2), f3 = __builtin_bit_cast(f16x8, w3);
            const f32x16 z = {};
            f32x16 ist = __builtin_amdgcn_mfma_f32_32x32x16_f16(T0, f0, z, 0, 0, 0);
            ist = __builtin_amdgcn_mfma_f32_32x32x16_f16(T1, f1, ist, 0, 0, 0);
            ist = __builtin_amdgcn_mfma_f32_32x32x16_f16(ONES, f2, ist, 0, 0, 0);
            ist = __builtin_amdgcn_mfma_f32_32x32x16_f16(ONES, f3, ist, 0, 0, 0);
            f32x16 isb = __builtin_amdgcn_mfma_f32_32x32x16_f16(T0, f2, z, 0, 0, 0);
            isb = __builtin_amdgcn_mfma_f32_32x32x16_f16(T1, f3, isb, 0, 0, 0);
#pragma unroll
            for (int r = 0; r < 16; ++r) { p0[r] = __builtin_amdgcn_exp2f((p0[r] - ist[r]) - carry); p1[r] = __builtin_amdgcn_exp2f((p1[r] - isb[r]) - carry); }
            const float tt = ist[0];
            carry += __shfl(tt, r32);
        } else {
            const float rm = rowmax(p0, p1);
            if (__any(rm > mhat + THR)) {
                const float mn = fmaxf(mhat, rm), f = __builtin_amdgcn_exp2f(mhat - mn);
                mhat = mn; l_reg *= f;
                if (hi == 0) wsf[r32] = f;
                asm volatile("s_waitcnt lgkmcnt(0)" ::: "memory");
#pragma unroll
                for (int r = 0; r < 16; ++r) { const float fr_ = wsf[crow(r, hi)]; o[0][r] *= fr_; o[1][r] *= fr_; }
            }
            float sacc = 0.f;
#pragma unroll
            for (int r = 0; r < 16; ++r) { p0[r] = __builtin_amdgcn_exp2f(p0[r] - mhat); p1[r] = __builtin_amdgcn_exp2f(p1[r] - mhat); sacc += p0[r] + p1[r]; }
            l_reg += sacc;
        }
        u32x4 pw0, pw1, pw2, pw3;
        pw0 = (u32x4){cvtpk_s(p0[0], p0[1]), cvtpk_s(p0[2], p0[3]), cvtpk_s(p0[4], p0[5]), cvtpk_s(p0[6], p0[7])};
        pw1 = (u32x4){cvtpk_s(p0[8], p0[9]), cvtpk_s(p0[10], p0[11]), cvtpk_s(p0[12], p0[13]), cvtpk_s(p0[14], p0[15])};
        pw2 = (u32x4){cvtpk_s(p1[0], p1[1]), cvtpk_s(p1[2], p1[3]), cvtpk_s(p1[4], p1[5]), cvtpk_s(p1[6], p1[7])};
        pw3 = (u32x4){cvtpk_s(p1[8], p1[9]), cvtpk_s(p1[10], p1[11]), cvtpk_s(p1[12], p1[13]), cvtpk_s(p1[14], p1[15])};
        __builtin_amdgcn_sched_barrier(0);
        pv(o, vb0 + slot, __builtin_bit_cast(bf16x8, pw0), __builtin_bit_cast(bf16x8, pw1), __builtin_bit_cast(bf16x8, pw2), __builtin_bit_cast(bf16x8, pw3));
    }
#undef DMA_K
#undef DMA_V
    float rl[16];
    if (MODE != 0) {
        auto rr = __builtin_amdgcn_permlane32_swap(__float_as_uint(l_reg), __float_as_uint(l_reg), false, false);
        const float lt = __uint_as_float(rr[0]) + __uint_as_float(rr[1]);
        if (hi == 0) wsf[32 + r32] = lt;
        asm volatile("s_waitcnt lgkmcnt(0)" ::: "memory");
#pragma unroll
        for (int r = 0; r < 16; ++r) rl[r] = 1.0f / wsf[32 + crow(r, hi)];
    } else {
#pragma unroll
        for (int r = 0; r < 16; ++r) rl[r] = 1.0f;
    }
    ALAS float* stg = (ALAS float*)(lds + L_OST + wid * OSTW);
#pragma unroll
    for (int r = 0; r < 16; ++r) { const int orow = crow(r, hi);
#pragma unroll
        for (int d0 = 0; d0 < 2; ++d0) stg[orow * 68 + d0 * 32 + r32] = o[d0][r] * rl[r]; }
    asm volatile("s_waitcnt lgkmcnt(0)" ::: "memory");
    const int hg = HG0 + h, ch = lane & 7;
    const f32x4 nw0 = *(const f32x4*)(A.onw + hg * HDIM + ch * 8), nw1 = *(const f32x4*)(A.onw + hg * HDIM + ch * 8 + 4);
#pragma unroll
    for (int i = 0; i < 4; ++i) {
        const int row = i * 8 + (lane >> 3);
        const f32x4 a = *(const ALAS f32x4*)(stg + row * 68 + ch * 8), c = *(const ALAS f32x4*)(stg + row * 68 + ch * 8 + 4);
        float ss = (a[0] * a[0] + a[1] * a[1]) + (a[2] * a[2] + a[3] * a[3]) + (c[0] * c[0] + c[1] * c[1]) + (c[2] * c[2] + c[3] * c[3]);
        ss += __shfl_xor(ss, 1); ss += __shfl_xor(ss, 2); ss += __shfl_xor(ss, 4);
        const float rstd = rsqrtf(ss * (1.0f / HDIM) + EPS);
        const size_t grow = trow0 + row;
        const u32x4 gv = *(const u32x4*)(A.proj + grow * NPROJ + PC_GATE + hg * HDIM + ch * 8);
        float g[8];
#pragma unroll
        for (int e = 0; e < 4; ++e) { g[2 * e] = __uint_as_float(gv[e] << 16); g[2 * e + 1] = __uint_as_float(gv[e] & 0xffff0000u); }
        float ov[8];
#pragma unroll
        for (int e = 0; e < 8; ++e) { const float val = (e < 4 ? a[e] : c[e - 4]) * rstd * (e < 4 ? nw0[e] : nw1[e - 4]); const float sg = g[e] / (1.0f + __expf(-g[e])); ov[e] = val * sg; }
        u32x4 w; w.x = cvtpk_s(ov[0], ov[1]); w.y = cvtpk_s(ov[2], ov[3]); w.z = cvtpk_s(ov[4], ov[5]); w.w = cvtpk_s(ov[6], ov[7]);
        *(u32x4*)(A.y + grow * MIX_W + hg * HDIM + ch * 8) = w;
    }
    asm volatile("s_waitcnt lgkmcnt(0)\n\ts_barrier" ::: "memory");
}
#undef AWAIT_BAR
}
constexpr int NWAVES = 8;
constexpr size_t MiB = 1u << 20;
constexpr size_t WS_CTL = 0, CTL_ZERO_BYTES = 64 * 1024;
constexpr size_t WS_WIN0 = 1 * MiB;
constexpr size_t WS_WIN1 = 13 * MiB;
constexpr size_t WS_WOUT = 23 * MiB;
constexpr size_t WS_XB = 28 * MiB;
constexpr size_t WS_PROJ = 64 * MiB;
constexpr size_t WS_Y = 208 * MiB;
constexpr size_t WS_MEMKV = 248 * MiB;
constexpr size_t WS_LOGF = 252 * MiB;
constexpr size_t WS_ST0 = 252 * MiB + 512 * 1024;
constexpr size_t WS_ST1 = WS_ST0 + (size_t)M_CAT * 64 + 64 * 1024;
constexpr size_t WS_ST2 = WS_ST1 + (size_t)M_TOK * 64;
constexpr size_t WS_END = WS_ST2 + (size_t)M_TOK * 64;
static_assert(WS_WIN0 + (size_t)(NPAD + 1024) * 1024 * 2 <= WS_WIN1 && WS_WIN1 + (size_t)NPAD * 1024 * 2 <= WS_WOUT && WS_WOUT + 2ull * 1024 * 1280 * 2 <= WS_XB &&
              WS_XB + (size_t)M_CAT * 1024 * 2 <= WS_PROJ && WS_PROJ + (size_t)M_TOK * NPROJ * 2 <= WS_Y && WS_Y + (size_t)M_TOK * MIX_W * 2 <= WS_MEMKV &&
              WS_MEMKV + 2ull * M_MEM * 512 * 2 <= WS_LOGF && WS_LOGF + 8ull * 8 * SEQ * 4 <= WS_ST0 && WS_END <= 256 * MiB, "d_ws map");
constexpr int CW_BAR = 1024;
static_assert((CW_BAR + XCD_BAR_WORDS) * 4 <= (int)CTL_ZERO_BYTES, "control words inside the memset region");
constexpr int RING_BYTES = 131072, MISC_OFF = RING_BYTES + 320, LDS_BYTES = 147456;
static_assert(att::L_END <= RING_BYTES, "attention scratch fits the ring region");

struct KArgs { const float* in[10]; float* out; unsigned char* ws; };

__device__ __forceinline__ float wave_sum(float v) {
#pragma unroll
    for (int o = 1; o < 64; o <<= 1) v += __shfl_xor(v, o);
    return v;
}
__device__ __forceinline__ void p0_item(const float* W, int N, int col0, int nvalid, const float* g, bf16* WT, int K, int drow0, int k0, LAS float* scr, int lane) {
#pragma unroll 8
    for (int i = 0; i < 32; ++i) { const int kk = 2 * i + (lane >> 5), c = lane & 31; float v = 0.f;
        if (c < nvalid) { v = W[(size_t)(k0 + kk) * N + col0 + c]; if (g) v *= g[k0 + kk]; }
        scr[kk * 33 + c] = v; }
    LDS_WAIT(); asm volatile("" ::: "memory");
    const int c8 = lane & 7;
#pragma unroll
    for (int j = 0; j < 4; ++j) { const int n = (lane >> 3) + 8 * j; const LAS float* s = scr + (8 * c8) * 33 + n;
        v4u o; o.x = pk2(s[0 * 33], s[1 * 33]); o.y = pk2(s[2 * 33], s[3 * 33]); o.z = pk2(s[4 * 33], s[5 * 33]); o.w = pk2(s[6 * 33], s[7 * 33]);
        *(GAS v4u*)(WT + (size_t)(drow0 + n) * K + k0 + 8 * c8) = o; }
    LDS_WAIT(); asm volatile("" ::: "memory");
}

__global__ void __launch_bounds__(NWAVES * 64, 2) mega_fwd(KArgs args) {
    extern __shared__ __attribute__((aligned(16))) unsigned char lds_raw[];
    LAS unsigned char* lds = (LAS unsigned char*)lds_raw;
    volatile LAS unsigned* MISC = (volatile LAS unsigned*)(lds + MISC_OFF);
    const int tid = threadIdx.x, lane = tid & 63, wave = __builtin_amdgcn_readfirstlane(tid >> 6);
    const int G = gridDim.x, bx = blockIdx.x, vcu = (G % 8 == 0) ? (bx % 8) * (G / 8) + bx / 8 : bx;
    unsigned char* ws = args.ws;
    const float* x = args.in[0]; const float* mem = args.in[1]; const float* norm_w = args.in[2]; const float* w_in = args.in[3]; const float* b_forget = args.in[4];
    const float* mem_norm_w = args.in[5]; const float* w_mem_kv = args.in[6]; const float* out_norm_w = args.in[7]; const float* w_out = args.in[8]; const float* final_norm_w = args.in[9];
    float* out = args.out;
    bf16* WIN0 = (bf16*)(ws + WS_WIN0); bf16* WIN1 = (bf16*)(ws + WS_WIN1); bf16* WOUT = (bf16*)(ws + WS_WOUT); bf16* XB = (bf16*)(ws + WS_XB);
    bf16* PROJ = (bf16*)(ws + WS_PROJ); bf16* Y = (bf16*)(ws + WS_Y); bf16* MEMKV = (bf16*)(ws + WS_MEMKV);
    float* LOGF = (float*)(ws + WS_LOGF); float* ST0 = (float*)(ws + WS_ST0); float* ST1 = (float*)(ws + WS_ST1); float* ST2 = (float*)(ws + WS_ST2);
    for (int u = tid; u < (LDS_BYTES - RING_BYTES) / 4; u += NWAVES * 64) ((LAS unsigned*)(lds + RING_BYTES))[u] = 0u;
    __syncthreads();
    XcdBarrier bar = xcd_barrier_post((unsigned*)(ws + WS_CTL) + CW_BAR, MISC + 8);
    const int gw = vcu * NWAVES + wave, NGW = G * NWAVES;

    {
        LAS float* scr = (LAS float*)(lds + wave * 16384);
        constexpr int I_IN = (NPAD / 32) * (D_MODEL / 64), I_MKV = (512 / 32) * (D_MODEL / 64), I_OUT = (D_MODEL / 32) * (MIX_W / 64), I_L = I_IN + I_MKV + I_OUT;
        for (int it = gw; it < 2 * I_L; it += NGW) {
            const int l = it / I_L; int r = it - l * I_L;
            if (r < I_IN) { const int nb = r % (NPAD / 32), kb = r / (NPAD / 32), n0 = 32 * nb;
                int col0, nv; if (n0 < 3072) { col0 = n0; nv = 32; } else if (n0 < NPROJ) { col0 = n0 + 8; nv = 32; } else if (n0 == NPROJ) { col0 = 3072; nv = 8; } else { col0 = 0; nv = 0; }
                p0_item(w_in + (size_t)l * D_MODEL * IN_W, IN_W, col0, nv, norm_w + l * D_MODEL, l == 0 ? WIN0 : WIN1, D_MODEL, n0, 64 * kb, scr, lane); continue; }
            r -= I_IN;
            if (r < I_MKV) { const int nb = r % 16, kb = r / 16;
                p0_item(w_mem_kv + (size_t)l * D_MODEL * 512, 512, 32 * nb, 32, mem_norm_w + l * D_MODEL, WIN0, D_MODEL, NPAD + l * 512 + 32 * nb, 64 * kb, scr, lane); continue; }
            r -= I_MKV;
            { const int nb = r % 32, kb = r / 32;
                p0_item(w_out + (size_t)l * MIX_W * D_MODEL, D_MODEL, 32 * nb, 32, nullptr, WOUT + (size_t)l * D_MODEL * MIX_W, MIX_W, 32 * nb, 64 * kb, scr, lane); }
        }
        for (int m = gw; m < M_CAT; m += NGW) {
            const float* src = m < M_TOK ? x + (size_t)m * D_MODEL : mem + (size_t)(m - M_TOK) * D_MODEL;
            const GAS f32x4* xr = (const GAS f32x4*)src + lane;
            f32x4 v[4]; float s = 0.f;
#pragma unroll
            for (int j = 0; j < 4; ++j) { v[j] = xr[64 * j]; s += (v[j].x * v[j].x + v[j].y * v[j].y) + (v[j].z * v[j].z + v[j].w * v[j].w); }
            s = wave_sum(s);
            GAS unsigned long long* o8 = (GAS unsigned long long*)(XB + (size_t)m * D_MODEL) + lane;
#pragma unroll
            for (int j = 0; j < 4; ++j) o8[64 * j] = (unsigned long long)pk2(v[j].x, v[j].y) | ((unsigned long long)pk2(v[j].z, v[j].w) << 32);
            if (lane < 16) ST0[(size_t)m * 16 + lane] = lane == 0 ? s : 0.f;
        }
    }
    xcd_barrier(bar);

    for (int layer = 0; layer < DEPTH; ++layer) {
        {
            pg8::Gemm g{XB, layer == 0 ? WIN0 : WIN1, M_CAT, NPAD, D_MODEL};
            pg8::OrderP1 S; S.init(G, bx, layer == 0 ? 32 : 0);
            pg8::EpiP1 E{PROJ, MEMKV, LOGF, layer == 0 ? ST0 : ST1, b_forget + layer * 8};
            pg8::gemm_phase<pg8::EpiP1, pg8::OrderP1, true, true>(lds, g, S, E);
        }
        xcd_barrier(bar);
        {
            const att::Args A{PROJ, MEMKV + (size_t)layer * M_MEM * 512, LOGF, out_norm_w + layer * MIX_W, Y};
            for (int slot = vcu; slot < 256; slot += G) {
                const int bh = slot >> 2, b = bh >> 3, h = bh & 7, s = slot & 3;
                att::attn_unit<0>(A, b, h, 7 - s, (LAS char*)lds);
                att::attn_unit<0>(A, b, h, s, (LAS char*)lds);
                att::attn_unit<1>(A, b, h, 7 - s, (LAS char*)lds);
                att::attn_unit<1>(A, b, h, s, (LAS char*)lds);
                att::attn_unit<2>(A, slot >> 5, (slot >> 3) & 3, slot & 7, (LAS char*)lds);
            }
        }
        xcd_barrier(bar);
        {
            pg8::Gemm g{Y, WOUT + (size_t)layer * D_MODEL * MIX_W, M_TOK, D_MODEL, MIX_W};
            pg8::StaticOrder S; S.init(M_TOK, D_MODEL, G, bx);
            pg8::EpiP3 E{layer == 0 ? x : out, out, XB, layer == 0 ? ST1 : ST2};
            pg8::gemm_phase<pg8::EpiP3, pg8::StaticOrder, true, true>(lds, g, S, E);
        }
        xcd_barrier(bar);
    }
    for (int m = gw; m < M_TOK; m += NGW) {
        const float rstd = pg8::row_rstd(ST2, m);
        GAS f32x4* xr = (GAS f32x4*)(out + (size_t)m * D_MODEL) + lane;
        const GAS f32x4* gr = (const GAS f32x4*)final_norm_w + lane;
#pragma unroll
        for (int j = 0; j < 4; ++j) { const f32x4 v = xr[64 * j], gg = gr[64 * j]; xr[64 * j] = v * rstd * gg; }
    }
}

extern "C" void kernel_launch(void* const* d_in, const int* in_sizes, int n_in, void* d_out, int out_size, void* d_ws, size_t ws_size, hipStream_t stream) {
    static int grid = 0;
    if (grid == 0) {
        if (n_in != 10 || out_size != M_TOK * D_MODEL || ws_size < WS_END) { fprintf(stderr, "kernel_launch: unexpected shapes / workspace (%d inputs, out %d, ws %zu, need %zu)\n", n_in, out_size, ws_size, (size_t)WS_END); grid = -1; return; }
        int dev = 0, cus = 0, per_cu = 0;
        if (hipGetDevice(&dev) != hipSuccess || hipDeviceGetAttribute(&cus, hipDeviceAttributeMultiprocessorCount, dev) != hipSuccess) { grid = -1; return; }
        if (hipFuncSetAttribute((const void*)mega_fwd, hipFuncAttributeMaxDynamicSharedMemorySize, LDS_BYTES) != hipSuccess) { fprintf(stderr, "kernel_launch: hipFuncSetAttribute failed\n"); grid = -1; return; }
        if (hipOccupancyMaxActiveBlocksPerMultiprocessor(&per_cu, (const void*)mega_fwd, NWAVES * 64, LDS_BYTES) != hipSuccess || per_cu < 1) { fprintf(stderr, "kernel_launch: occupancy query says %d blocks per CU\n", per_cu); (void)hipGetLastError(); grid = -1; return; }
        grid = cus;
    }
    if (grid < 0) return;
    if (hipMemsetAsync((char*)d_ws + WS_CTL, 0, CTL_ZERO_BYTES, stream) != hipSuccess) return;
    KArgs a{};
    for (int i = 0; i < 10; ++i) a.in[i] = (const float*)d_in[i];
    a.out = (float*)d_out; a.ws = (unsigned char*)d_ws;
    hipLaunchKernelGGL(mega_fwd, dim3(grid), dim3(NWAVES * 64), LDS_BYTES, stream, a);
}
```

```cpp
#include <hip/hip_runtime.h>
#include <cstdio>
#include <cstdint>
#include <cmath>

constexpr int D_MODEL = 1024, BATCH = 8, SEQ = 2048, DEPTH = 2, MEM_LEN = 256, HDIM = 64;
constexpr int M_TOK = BATCH * SEQ;
constexpr int M_MEM = BATCH * MEM_LEN;
constexpr int M_CAT = M_TOK + M_MEM;
constexpr int IN_W = 4616, MIX_W = 1280;
constexpr int NPROJ = 4608;
constexpr int NPAD = 4864;
constexpr int PC_SBQ = 0, PC_SBK = 512, PC_SBV = 1024, PC_FXQ = 1536, PC_FXK = 2048, PC_FXV = 2560, PC_MQ = 3072, PC_GATE = 3328;
constexpr float EPS = 1e-6f;
constexpr float LOG2E = 1.4426950408889634f;
constexpr float C2 = 0.125f * LOG2E;
namespace pg8 {
#define PG8_LAS __attribute__((address_space(3)))
typedef unsigned short bf16_t;
typedef short bf16x8 __attribute__((ext_vector_type(8)));
typedef float f32x4 __attribute__((ext_vector_type(4)));
typedef unsigned u32x4 __attribute__((ext_vector_type(4)));
constexpr int BM = 256, BK = 64, HALF = 128, HTB = HALF * BK * 2  , STAGE_BYTES = 8 * HTB, NXCD = 8, WGM = 8;

__host__ __device__ __forceinline__ int lds_byte(int r, int c) { const int st = (r >> 4) * 2 + (c >> 5), rr = r & 15, cc = c & 31, ob = rr * 64 + cc * 2; return st * 1024 + (ob ^ (((ob >> 9) & 1) << 5)); }
__host__ __device__ __forceinline__ void stage_rc(int b, int& R, int& C) { const int st = b / 1024, sb = b % 1024, swz = sb ^ (((sb >> 9) & 1) << 5); R = (st >> 1) * 16 + swz / 64; C = (st & 1) * 32 + (swz % 64) / 2; }
__host__ __device__ __forceinline__ int perm32(int rho) { const int n = rho >> 4, i = rho & 15; return 8 * (i >> 2) + 4 * n + (i & 3); }

struct Unit { int pm, pn; };
struct Gemm { const bf16_t* A; const bf16_t* Bt; int M, N, K; };

struct StaticOrder {
    int nM, nN, nwg, G, c;
    __host__ __device__ void init(int M, int N, int G_, int c_) { nM = M / BM; nN = N / BM; nwg = nM * nN; G = G_; c = c_; }
    __host__ __device__ bool next(int i, Unit& u) const {
        const long L = (long)i * G + c; if (L >= nwg) return false;
        int wgid = (int)L; { const int q = nwg / NXCD, r = nwg % NXCD, xcd = wgid % NXCD, off = wgid / NXCD; wgid = (xcd < r ? xcd * (q + 1) : r * (q + 1) + (xcd - r) * q) + off; }
        const int nig = WGM * nN, gid = wgid / nig, fm = gid * WGM, gsz = (nM - fm) < WGM ? (nM - fm) : WGM;
        u.pm = fm + ((wgid % nig) % gsz); u.pn = (wgid % nig) / gsz; return true;
    }
    __device__ __forceinline__ void a_ready(const Unit&) const {}
    __device__ __forceinline__ void done(const Unit&) const {}
};
__device__ __forceinline__ unsigned cvt_pk_bf16(float lo, float hi) { unsigned r; asm volatile("v_cvt_pk_bf16_f32 %0, %1, %2" : "=v"(r) : "v"(lo), "v"(hi)); return r; }
typedef float f32x2 __attribute__((ext_vector_type(2)));

struct OrderP1 {
    StaticOrder so; int nextra;
    __device__ void init(int G_, int c_, int nextra_) { so.init(M_TOK, NPAD, G_, c_); nextra = nextra_; }
    __device__ bool next(int i, Unit& u) const {
        const long L = (long)i * so.G + so.c;
        if (L < so.nwg) return so.next(i, u);
        const int e = (int)(L - so.nwg); if (e >= nextra) return false;
        u.pm = 64 + (e >> 2); u.pn = 19 + (e & 3); return true;
    }
    __device__ __forceinline__ void a_ready(const Unit&) const {}
    __device__ __forceinline__ void done(const Unit&) const {}
};
__device__ __forceinline__ float row_rstd(const float* stats, int r) {
    const f32x4* sp = (const f32x4*)(stats + (size_t)r * 16);
    const f32x4 a = sp[0], b = sp[1], c = sp[2], d = sp[3];
    const float s = ((a[0] + a[1]) + (a[2] + a[3])) + ((b[0] + b[1]) + (b[2] + b[3])) + ((c[0] + c[1]) + (c[2] + c[3])) + ((d[0] + d[1]) + (d[2] + d[3]));
    return rsqrtf(s * (1.0f / D_MODEL) + EPS);
}
__device__ __forceinline__ float log_sigmoid_f(float f) { return fminf(f, 0.f) - log1pf(expf(-fabsf(f))); }
struct EpiP1 {
    static constexpr bool PERM = true, AFTER_DRAIN = false;
    bf16_t* proj; bf16_t* memkv; float* lgf; const float* stats; const float* bforget; unsigned* kn;
    __device__ __forceinline__ void operator()(const f32x4 (&acc)[2][2][4][2], const Unit& u, int wr, int wc, int fr, int fq) const {
        const int row0 = u.pm * BM + wr * 64 + fr;
        float rs[2][4];
#pragma unroll
        for (int ai = 0; ai < 2; ++ai)
#pragma unroll
            for (int m = 0; m < 4; ++m) rs[ai][m] = row_rstd(stats, row0 + ai * HALF + m * 16);
        if (u.pm < 64 && u.pn == 18) {
            if (wc == 0 && fq == 0) {
                float bf[8];
#pragma unroll
                for (int j = 0; j < 8; ++j) bf[j] = bforget[j];
#pragma unroll
                for (int ai = 0; ai < 2; ++ai)
#pragma unroll
                    for (int m = 0; m < 4; ++m) { const int r = row0 + ai * HALF + m * 16, b = r >> 11, s = r & 2047; float* lp = lgf + (size_t)b * 8 * SEQ + s;
#pragma unroll
                        for (int j = 0; j < 4; ++j) { lp[(size_t)j * SEQ] = log_sigmoid_f(acc[ai][0][m][0][j] * rs[ai][m] + bf[j]); lp[(size_t)(4 + j) * SEQ] = log_sigmoid_f(acc[ai][0][m][1][j] * rs[ai][m] + bf[4 + j]); } }
            }
            return;
        }
        bf16_t* base; size_t pitch; float sc = 1.f; int colt;
        if (u.pm < 64) { base = proj + (size_t)row0 * NPROJ; pitch = NPROJ; colt = u.pn * BM; if (u.pn < 2 || u.pn == 6 || u.pn == 7 || u.pn == 12) sc = C2; }
        else { const int t = u.pn - 19; base = memkv + (size_t)(t >> 1) * M_MEM * 512 + (size_t)(row0 - M_TOK) * 512; pitch = 512; colt = (t & 1) * BM; }
        const int col0 = colt + wc * 32 + 8 * fq;
        if (u.pm < 64 && (u.pn == 8 || u.pn == 9)) {
#pragma unroll
            for (int bj = 0; bj < 2; ++bj) { float mx = 0.f;
#pragma unroll
                for (int ai = 0; ai < 2; ++ai)
#pragma unroll
                    for (int m = 0; m < 4; ++m) { const f32x4 v0 = acc[ai][bj][m][0] * rs[ai][m], v1 = acc[ai][bj][m][1] * rs[ai][m];
                        float ss = (v0[0] * v0[0] + v0[1] * v0[1]) + (v0[2] * v0[2] + v0[3] * v0[3]) + (v1[0] * v1[0] + v1[1] * v1[1]) + (v1[2] * v1[2] + v1[3] * v1[3]);
                        ss += __shfl_xor(ss, 16); ss += __shfl_xor(ss, 32); mx = fmaxf(mx, ss); }
                mx = fmaxf(mx, __shfl_xor(mx, 1)); mx = fmaxf(mx, __shfl_xor(mx, 2)); mx = fmaxf(mx, __shfl_xor(mx, 4)); mx = fmaxf(mx, __shfl_xor(mx, 8));
                if (fr == 0 && fq == 0) atomicMax(kn + (((u.pm >> 3) * 8 + (u.pn - 8) * 4 + bj * 2 + (wc >> 1)) * 2 + (wc & 1)), __float_as_uint(mx)); }
        }
#pragma unroll
        for (int ai = 0; ai < 2; ++ai)
#pragma unroll
            for (int m = 0; m < 4; ++m) { bf16_t* rowp = base + (size_t)(ai * HALF + m * 16) * pitch + col0; const float s = rs[ai][m] * sc;
#pragma unroll
                for (int bj = 0; bj < 2; ++bj) { const f32x4 v0 = acc[ai][bj][m][0] * s, v1 = acc[ai][bj][m][1] * s;
                    u32x4 w; w.x = cvt_pk_bf16(v0[0], v0[1]); w.y = cvt_pk_bf16(v0[2], v0[3]); w.z = cvt_pk_bf16(v1[0], v1[1]); w.w = cvt_pk_bf16(v1[2], v1[3]);
                    *(u32x4*)(rowp + bj * HALF) = w; } }
    }
};
struct EpiP3 {
    static constexpr bool PERM = true, AFTER_DRAIN = false;
    const float* xin; float* xout; bf16_t* xb; float* stats;
    __device__ __forceinline__ void operator()(const f32x4 (&acc)[2][2][4][2], const Unit& u, int wr, int wc, int fr, int fq) const {
        const int row0 = u.pm * BM + wr * 64 + fr, col0 = u.pn * BM + wc * 32 + 8 * fq;
#pragma unroll
        for (int ai = 0; ai < 2; ++ai)
#pragma unroll
            for (int m = 0; m < 4; ++m) { const int r = row0 + ai * HALF + m * 16; float ss = 0.f;
#pragma unroll
                for (int bj = 0; bj < 2; ++bj) { const size_t off = (size_t)r * D_MODEL + col0 + bj * HALF;
                    const f32x4 x0 = *(const f32x4*)(xin + off), x1 = *(const f32x4*)(xin + off + 4);
                    const f32x4 v0 = acc[ai][bj][m][0] + x0, v1 = acc[ai][bj][m][1] + x1;
                    *(f32x4*)(xout + off) = v0; *(f32x4*)(xout + off + 4) = v1;
                    ss += (v0[0] * v0[0] + v0[1] * v0[1]) + (v0[2] * v0[2] + v0[3] * v0[3]) + (v1[0] * v1[0] + v1[1] * v1[1]) + (v1[2] * v1[2] + v1[3] * v1[3]);
                    u32x4 w; w.x = cvt_pk_bf16(v0[0], v0[1]); w.y = cvt_pk_bf16(v0[2], v0[3]); w.z = cvt_pk_bf16(v1[0], v1[1]); w.w = cvt_pk_bf16(v1[2], v1[3]);
                    *(u32x4*)(xb + off) = w; }
                ss += __shfl_xor(ss, 16); ss += __shfl_xor(ss, 32);
                if (fq == 0) stats[(size_t)r * 16 + u.pn * 4 + wc] = ss; }
    }
};

template <class Epi, class Sched, bool ALIGN_EPI = false, bool SP2 = false>
__device__ __forceinline__ void gemm_phase(PG8_LAS unsigned char* lds, const Gemm g, const Sched& S, const Epi& E) {
    int tid_ = threadIdx.x; asm volatile("" : "+v"(tid_));
    const int tid = tid_, wid = __builtin_amdgcn_readfirstlane(tid >> 6), lane = tid & 63, wr = wid >> 2, wc = wid & 3, fr = lane & 15, fq = lane >> 4;
    const int K = g.K, nt = K / BK;
    unsigned voffA[2], voffB[2];
#pragma unroll
    for (int i = 0; i < 2; ++i) { int R, C; stage_rc(tid * 16 + i * 8192, R, C); const int Rb = Epi::PERM ? ((R & ~31) + perm32(R & 31)) : R;
        voffA[i] = (unsigned)(R * K + C) * 2u; voffB[i] = (unsigned)(Rb * K + C) * 2u; }
    const size_t kstep = (size_t)(BK * 2);
    const size_t hstep = (size_t)HALF * K * 2;
    const size_t tstep = 2 * hstep;
    const unsigned ldsw = (unsigned)wid * 1024u;
    const int aoff = lds_byte(wr * 64 + fr, fq * 8), boff = lds_byte(wc * 32 + fr, fq * 8);
#define PG8_SA(b, h) (((b) * 2 + (h)) * HTB)
#define PG8_SB(b, h) ((4 + (b) * 2 + (h)) * HTB)
#define PG8_STAGE(bufoff, gbase, voff) do { _Pragma("unroll") for (int _i = 0; _i < 2; ++_i) \
        __builtin_amdgcn_global_load_lds((const unsigned*)((const char*)(gbase) + (voff)[_i]), (PG8_LAS unsigned*)(lds + (bufoff) + ldsw + _i * 8192), 16, 0, 0); } while (0)
#define PG8_LDA(dst, b, h) do { _Pragma("unroll") for (int m = 0; m < 4; ++m) _Pragma("unroll") for (int k = 0; k < 2; ++k) dst[m][k] = *(const PG8_LAS bf16x8*)(lds + PG8_SA(b, h) + aoff + m * 2048 + k * 1024); } while (0)
#define PG8_LDB(dst, b, h) do { _Pragma("unroll") for (int n = 0; n < 2; ++n) _Pragma("unroll") for (int k = 0; k < 2; ++k) dst[n][k] = *(const PG8_LAS bf16x8*)(lds + PG8_SB(b, h) + boff + n * 2048 + k * 1024); } while (0)
#define PG8_MMA(ai, bj, At, Bt) do { __builtin_amdgcn_s_setprio(1); _Pragma("unroll") for (int m = 0; m < 4; ++m) _Pragma("unroll") for (int n = 0; n < 2; ++n) _Pragma("unroll") for (int k = 0; k < 2; ++k) \
        acc[ai][bj][m][n] = __builtin_amdgcn_mfma_f32_16x16x32_bf16(Bt[n][k], At[m][k], acc[ai][bj][m][n], 0, 0, 0); __builtin_amdgcn_s_setprio(0); } while (0)
#define PG8_WAIT_V(n) asm volatile("s_waitcnt vmcnt(" #n ")" ::: "memory")
#define PG8_WAIT_L(n) asm volatile("s_waitcnt lgkmcnt(" #n ")" ::: "memory")
#define PG8_BAR __builtin_amdgcn_s_barrier()
#define PG8_SCHED __builtin_amdgcn_sched_barrier(0)
    Unit cur, nxt; int ui = 0;
    if (!S.next(0, cur)) return;
    f32x4 acc[2][2][4][2];
#pragma unroll
    for (int a = 0; a < 2; ++a)
#pragma unroll
        for (int b = 0; b < 2; ++b)
#pragma unroll
            for (int m = 0; m < 4; ++m)
#pragma unroll
                for (int n = 0; n < 2; ++n) acc[a][b][m][n] = (f32x4){0.f, 0.f, 0.f, 0.f};
    bf16x8 At[4][2], B0[2][2], B1[2][2];
    const char* cA = (const char*)g.A + (size_t)cur.pm * tstep; const char* cB = (const char*)g.Bt + (size_t)cur.pn * tstep;
    S.a_ready(cur);
    if constexpr (SP2) {
        PG8_STAGE(PG8_SB(0, 0), cB, voffB); PG8_STAGE(PG8_SB(0, 1), cB + hstep, voffB); PG8_STAGE(PG8_SA(0, 0), cA, voffA); PG8_STAGE(PG8_SA(0, 1), cA + hstep, voffA);
        if (wr == 1) PG8_BAR;
        PG8_WAIT_V(2); PG8_BAR;
        PG8_STAGE(PG8_SB(1, 0), cB + kstep, voffB); PG8_STAGE(PG8_SA(1, 0), cA + kstep, voffA); PG8_STAGE(PG8_SB(1, 1), cB + hstep + kstep, voffB);
        PG8_WAIT_V(6); PG8_BAR;
    } else {
        PG8_STAGE(PG8_SB(0, 0), cB, voffB); PG8_STAGE(PG8_SA(0, 0), cA, voffA); PG8_STAGE(PG8_SB(0, 1), cB + hstep, voffB); PG8_STAGE(PG8_SA(0, 1), cA + hstep, voffA);
        if (wr == 1) PG8_BAR;
        PG8_WAIT_V(4); PG8_BAR;
        PG8_STAGE(PG8_SB(1, 0), cB + kstep, voffB); PG8_STAGE(PG8_SA(1, 0), cA + kstep, voffA); PG8_STAGE(PG8_SB(1, 1), cB + hstep + kstep, voffB);
        PG8_WAIT_V(6); PG8_BAR;
    }
    for (;;) {
        const bool has_next = S.next(ui + 1, nxt);
        const char* nA = has_next ? (const char*)g.A + (size_t)nxt.pm * tstep : cA; const char* nB = has_next ? (const char*)g.Bt + (size_t)nxt.pn * tstep : cB;
        for (int t = 0; t < nt; t += 2) {
            const bool last = (t == nt - 2);
            const char* a1 = cA + (size_t)(t + 1) * kstep;
            const char* a2 = last ? nA : cA + (size_t)(t + 2) * kstep; const char* b2 = last ? nB : cB + (size_t)(t + 2) * kstep;
            const char* a3 = a2 + kstep; const char* b3 = b2 + kstep;
            if (last && has_next) S.a_ready(nxt);
            if constexpr (SP2) {
            PG8_LDB(B0, 0, 0); PG8_LDB(B1, 0, 1); PG8_SCHED; PG8_LDA(At, 0, 0); PG8_STAGE(PG8_SA(1, 1), a1 + hstep, voffA);
            PG8_WAIT_V(8); PG8_WAIT_L(0); PG8_BAR; PG8_MMA(0, 0, At, B0); PG8_MMA(0, 1, At, B1); PG8_BAR; PG8_SCHED;
            PG8_LDA(At, 0, 1); PG8_STAGE(PG8_SB(0, 0), b2, voffB); PG8_STAGE(PG8_SB(0, 1), b2 + hstep, voffB); PG8_STAGE(PG8_SA(0, 0), a2, voffA);
            PG8_WAIT_V(8); PG8_WAIT_L(0); PG8_BAR; PG8_MMA(1, 0, At, B0); PG8_MMA(1, 1, At, B1); PG8_BAR; PG8_SCHED;
            PG8_LDB(B0, 1, 0); PG8_LDB(B1, 1, 1); PG8_SCHED; PG8_LDA(At, 1, 0); PG8_STAGE(PG8_SA(0, 1), a2 + hstep, voffA);
            PG8_WAIT_V(8); PG8_WAIT_L(0); PG8_BAR; PG8_MMA(0, 0, At, B0); PG8_MMA(0, 1, At, B1); PG8_BAR; PG8_SCHED;
            PG8_LDA(At, 1, 1); PG8_STAGE(PG8_SB(1, 0), b3, voffB); PG8_STAGE(PG8_SB(1, 1), b3 + hstep, voffB); PG8_STAGE(PG8_SA(1, 0), a3, voffA);
            PG8_WAIT_V(8); PG8_WAIT_L(0); PG8_BAR; PG8_MMA(1, 0, At, B0); PG8_MMA(1, 1, At, B1); PG8_BAR; PG8_SCHED;
            } else {
            PG8_LDB(B0, 0, 0); PG8_SCHED; PG8_LDA(At, 0, 0); PG8_STAGE(PG8_SA(1, 1), a1 + hstep, voffA);
            PG8_WAIT_L(8); PG8_BAR; PG8_WAIT_L(0); PG8_MMA(0, 0, At, B0); PG8_BAR; PG8_SCHED;
            PG8_LDB(B1, 0, 1); PG8_STAGE(PG8_SB(0, 0), b2, voffB);
            PG8_BAR; PG8_WAIT_L(0); PG8_MMA(0, 1, At, B1); PG8_BAR;
            PG8_LDA(At, 0, 1); PG8_STAGE(PG8_SA(0, 0), a2, voffA);
            PG8_BAR; PG8_WAIT_L(0); PG8_MMA(1, 0, At, B0); PG8_BAR; PG8_SCHED;
            PG8_STAGE(PG8_SB(0, 1), b2 + hstep, voffB);
            PG8_WAIT_V(6); PG8_BAR; PG8_MMA(1, 1, At, B1); PG8_BAR;
            PG8_LDB(B0, 1, 0); PG8_SCHED; PG8_LDA(At, 1, 0); PG8_STAGE(PG8_SA(0, 1), a2 + hstep, voffA);
            PG8_WAIT_L(8); PG8_BAR; PG8_WAIT_L(0); PG8_MMA(0, 0, At, B0); PG8_BAR; PG8_SCHED;
            PG8_LDB(B1, 1, 1); PG8_STAGE(PG8_SB(1, 0), b3, voffB);
            PG8_BAR; PG8_WAIT_L(0); PG8_MMA(0, 1, At, B1); PG8_BAR;
            PG8_LDA(At, 1, 1); PG8_STAGE(PG8_SA(1, 0), a3, voffA);
            PG8_BAR; PG8_WAIT_L(0); PG8_MMA(1, 0, At, B0); PG8_BAR; PG8_SCHED;
            PG8_STAGE(PG8_SB(1, 1), b3 + hstep, voffB);
            PG8_WAIT_V(6); PG8_BAR; PG8_MMA(1, 1, At, B1); PG8_BAR;
            }
        }
        if constexpr (ALIGN_EPI) { if (wr == 0) PG8_BAR; }
        if constexpr (!Epi::AFTER_DRAIN) { E(acc, cur, wr, wc, fr, fq); S.done(cur); }
        if (!has_next) break;
#pragma unroll
        for (int a = 0; a < 2; ++a)
#pragma unroll
            for (int b = 0; b < 2; ++b)
#pragma unroll
                for (int m = 0; m < 4; ++m)
#pragma unroll
                    for (int n = 0; n < 2; ++n) acc[a][b][m][n] = (f32x4){0.f, 0.f, 0.f, 0.f};
        cur = nxt; cA = nA; cB = nB; ++ui;
        if constexpr (ALIGN_EPI) { if (wr == 1) PG8_BAR; }
    }
    PG8_WAIT_V(0);
    if constexpr (!ALIGN_EPI) { if (wr == 0) PG8_BAR; }
    PG8_BAR;
    if constexpr (Epi::AFTER_DRAIN) { E.fused(acc, cur, wr, wc, fr, fq, lds, wid, lane); S.done(cur); }
#undef PG8_SA
#undef PG8_SB
#undef PG8_STAGE
#undef PG8_LDA
#undef PG8_LDB
#undef PG8_MMA
#undef PG8_WAIT_V
#undef PG8_WAIT_L
#undef PG8_BAR
#undef PG8_SCHED
}
}
#define GAS __attribute__((address_space(1)))
#define LAS __attribute__((address_space(3)))
typedef unsigned short bf16;
typedef unsigned v4u __attribute__((ext_vector_type(4)));
typedef float f32x4 __attribute__((ext_vector_type(4)));
typedef short bf16x8 __attribute__((ext_vector_type(8)));
typedef GAS unsigned gu32;
typedef GAS unsigned long long gu64;
#define RLX_AGENT __ATOMIC_RELAXED, __HIP_MEMORY_SCOPE_AGENT
#define LDS_WAIT() asm volatile("s_waitcnt lgkmcnt(0)" ::: "memory")
#define VM_WAIT() asm volatile("s_waitcnt vmcnt(0)" ::: "memory")
__device__ __forceinline__ unsigned long long rt() { return __builtin_amdgcn_s_memrealtime(); }
__device__ __forceinline__ unsigned f2bf(float f) { unsigned u = __builtin_bit_cast(unsigned, f); return (u + 0x7fffu + ((u >> 16) & 1u)) >> 16; }
__device__ __forceinline__ unsigned pk2(float lo, float hi) { return f2bf(lo) | (f2bf(hi) << 16); }

#define XB_TMO      128
#define XB_XCNT(j)  (256  + 64 * (j))
#define XB_XSUB(j)  (1280 + 64 * (j))
#define XB_XGEN(j)  (2304 + 64 * (j))
#define XB_TOP      3328
#define XB_TOPGEN   3392
#define XCD_BAR_WORDS 3456
#define XB_SPIN_CAP (1u << 18)

__device__ __forceinline__ unsigned xb_ld(unsigned* p)              { return __hip_atomic_load(p, __ATOMIC_RELAXED, __HIP_MEMORY_SCOPE_AGENT); }
__device__ __forceinline__ unsigned xb_add(unsigned* p, unsigned v) { return __hip_atomic_fetch_add(p, v, __ATOMIC_RELAXED, __HIP_MEMORY_SCOPE_AGENT); }
__device__ __forceinline__ unsigned xb_xcc_id() { return (unsigned)__builtin_amdgcn_s_getreg((3 << 11) | 20) & 0xFu; }
#define XB_SPIN(cond, bar) do { unsigned _sp = 0; while (cond) { __builtin_amdgcn_s_sleep(1); \
    if ((++_sp & 255u) == 0u) { if (xb_ld(&(bar)[XB_TMO])) break; if (_sp > XB_SPIN_CAP) { atomicAdd(&(bar)[XB_TMO], 1u); break; } } } } while (0)

struct XcdBarrier {
    unsigned* bar; unsigned x;
    volatile LAS unsigned* st;
};

__device__ __forceinline__ XcdBarrier xcd_barrier_post(unsigned* bar, volatile LAS unsigned* st) {
    XcdBarrier b; b.bar = bar; b.x = xb_xcc_id(); b.st = st;
    if (threadIdx.x == 0) (void)xb_add(&bar[XB_XCNT(b.x)], 1u);
    return b;
}
__device__ __forceinline__ void xcd_barrier_complete(unsigned* bar, unsigned x, unsigned& nloc, unsigned& nx) {
    const unsigned G = gridDim.x * gridDim.y * gridDim.z;
    unsigned sum, cnt, mine, sp = 0u;
    for (;;) {
        sum = 0u; cnt = 0u; mine = 0u;
#pragma unroll
        for (unsigned j = 0; j < 16; ++j) { const unsigned c = xb_ld(&bar[XB_XCNT(j)]); sum += c; cnt += (c > 0u) ? 1u : 0u; mine = (j == x) ? c : mine; }
        if (sum == G) break;
        __builtin_amdgcn_s_sleep(1);
        if ((++sp & 255u) == 0u) { if (xb_ld(&bar[XB_TMO])) break; if (sp > XB_SPIN_CAP) { atomicAdd(&bar[XB_TMO], 1u); break; } }
    }
    nloc = mine > 0u ? mine : 1u; nx = cnt > 0u ? cnt : 1u;
}

__device__ __forceinline__ void xcd_barrier(const XcdBarrier& b) {
    asm volatile("s_waitcnt vmcnt(0)" ::: "memory");
    __syncthreads();
    if (threadIdx.x == 0) {
        unsigned* bar = b.bar;
        __builtin_amdgcn_s_waitcnt(0);
        unsigned nloc = b.st[0], nx = b.st[1];
        if (nloc == 0u) { xcd_barrier_complete(bar, b.x, nloc, nx); b.st[0] = nloc; b.st[1] = nx; }
        const unsigned old = xb_add(&bar[XB_XSUB(b.x)], 1u);
        const unsigned gen = old / nloc;
        if (old + 1u == (gen + 1u) * nloc) {
            __builtin_amdgcn_fence(__ATOMIC_RELEASE, "agent");
            asm volatile("s_waitcnt vmcnt(0)" ::: "memory");
            const unsigned og = xb_add(&bar[XB_TOP], 1u);
            const unsigned tg = og / nx;
            if (og + 1u == (tg + 1u) * nx) xb_add(&bar[XB_TOPGEN], 1u);
            else XB_SPIN(xb_ld(&bar[XB_TOPGEN]) == tg, bar);
            __builtin_amdgcn_fence(__ATOMIC_ACQUIRE, "agent");
            xb_add(&bar[XB_XGEN(b.x)], 1u);
            asm volatile("s_waitcnt vmcnt(0)" ::: "memory");
        } else {
            XB_SPIN(xb_ld(&bar[XB_XGEN(b.x)]) == gen, bar);
            __builtin_amdgcn_fence(__ATOMIC_ACQUIRE, "agent");
            asm volatile("s_waitcnt vmcnt(0)" ::: "memory");
        }
    }
    __syncthreads();
}
namespace att {
typedef short bf16x8 __attribute__((ext_vector_type(8)));
typedef _Float16 f16x8 __attribute__((ext_vector_type(8)));
typedef _Float16 f16x2 __attribute__((ext_vector_type(2)));
typedef short s16x4 __attribute__((ext_vector_type(4)));
typedef float f32x16 __attribute__((ext_vector_type(16)));
typedef float f32x4 __attribute__((ext_vector_type(4)));
typedef float f32x2_t __attribute__((ext_vector_type(2)));
typedef __bf16 bf16x2_t __attribute__((ext_vector_type(2)));
typedef unsigned u32x4 __attribute__((ext_vector_type(4)));
typedef unsigned short bf16;
#define ALAS __attribute__((address_space(3)))
constexpr int SLOTB = 8192, NRES = 7;
constexpr int L_K = 0, L_V = NRES * SLOTB, L_WS = 2 * NRES * SLOTB, L_CB = L_WS + 2048, L_SC = L_CB + SEQ * 4, L_FLG = L_SC + 64, L_END = L_FLG + 64;
constexpr int OSTW = 32 * 68 * 4;
static_assert(8 * OSTW <= 2 * NRES * SLOTB, "O stage fits the K/V region");
constexpr float THR = 8.f;
__device__ __forceinline__ int crow(int r, int hi) { return (r & 3) + 8 * (r >> 2) + 4 * hi; }
__device__ __forceinline__ void glds16(const void* gsrc, unsigned lds_dst) { unsigned keep;
    asm volatile("s_mov_b32 %0, m0\n\ts_mov_b32 m0, %2\n\ts_nop 0\n\tglobal_load_lds_dwordx4 %1, off\n\ts_mov_b32 m0, %0" : "=&s"(keep) : "v"(gsrc), "s"(lds_dst) : "memory"); }
__device__ __forceinline__ unsigned cvtpk_s(float lo, float hi) { f32x2_t v = {lo, hi}; bf16x2_t b = __builtin_convertvector(v, bf16x2_t); return __builtin_bit_cast(unsigned, b); }
__device__ __forceinline__ unsigned cvtpk_h(float lo, float hi) { f32x2_t v = {lo, hi}; f16x2 b = __builtin_convertvector(v, f16x2); return __builtin_bit_cast(unsigned, b); }
__device__ __forceinline__ float bf2f(unsigned short x) { return __uint_as_float((unsigned)x << 16); }
#define AWAIT_BAR(N) asm volatile("s_waitcnt vmcnt(" #N ") lgkmcnt(0)\n\ts_barrier" ::: "memory")
__device__ __forceinline__ void qkt(f32x16& p0, f32x16& p1, const ALAS char* kb, const bf16x8* qr) {
    const f32x16 z = {};
#pragma unroll
    for (int d0 = 0; d0 < 4; ++d0) {
        const bf16x8 b0 = *(const ALAS bf16x8*)(kb + d0 * 2048);
        const bf16x8 b1 = *(const ALAS bf16x8*)(kb + d0 * 2048 + 512);
        if (d0 == 0) { p0 = __builtin_amdgcn_mfma_f32_32x32x16_bf16(b0, qr[0], z, 0, 0, 0); p1 = __builtin_amdgcn_mfma_f32_32x32x16_bf16(b1, qr[0], z, 0, 0, 0); }
        else { p0 = __builtin_amdgcn_mfma_f32_32x32x16_bf16(b0, qr[d0], p0, 0, 0, 0); p1 = __builtin_amdgcn_mfma_f32_32x32x16_bf16(b1, qr[d0], p1, 0, 0, 0); } }
}
__device__ __forceinline__ void pv(f32x16* o, int vb, bf16x8 pa0, bf16x8 pa1, bf16x8 pa2, bf16x8 pa3) {
#pragma unroll
    for (int d0 = 0; d0 < 2; ++d0) { s16x4 lo[4], hi[4];
#pragma unroll
        for (int ks = 0; ks < 4; ++ks) {
            asm volatile("ds_read_b64_tr_b16 %0,%1 offset:%c2" : "=&v"(lo[ks]) : "v"(vb), "i"(d0 * 4096 + ks * 1024) : "memory");
            asm volatile("ds_read_b64_tr_b16 %0,%1 offset:%c2" : "=&v"(hi[ks]) : "v"(vb), "i"(d0 * 4096 + ks * 1024 + 512) : "memory"); }
        asm volatile("s_waitcnt lgkmcnt(0)" ::: "memory"); __builtin_amdgcn_sched_barrier(0);
#define ATT_PK(k) (bf16x8){lo[k][0], lo[k][1], lo[k][2], lo[k][3], hi[k][0], hi[k][1], hi[k][2], hi[k][3]}
        o[d0] = __builtin_amdgcn_mfma_f32_32x32x16_bf16(pa0, ATT_PK(0), o[d0], 0, 0, 0);
        o[d0] = __builtin_amdgcn_mfma_f32_32x32x16_bf16(pa1, ATT_PK(1), o[d0], 0, 0, 0);
        o[d0] = __builtin_amdgcn_mfma_f32_32x32x16_bf16(pa2, ATT_PK(2), o[d0], 0, 0, 0);
        o[d0] = __builtin_amdgcn_mfma_f32_32x32x16_bf16(pa3, ATT_PK(3), o[d0], 0, 0, 0);
#undef ATT_PK
    }
}
__device__ __forceinline__ float rowmax(const f32x16& p0, const f32x16& p1) {
    float a = fmaxf(p0[0], p1[0]);
#pragma unroll
    for (int r = 1; r < 16; ++r) a = fmaxf(a, fmaxf(p0[r], p1[r]));
    auto rr = __builtin_amdgcn_permlane32_swap(__float_as_uint(a), __float_as_uint(a), false, false);
    return fmaxf(__uint_as_float(rr[0]), __uint_as_float(rr[1]));
}
struct Args { const bf16* proj; const bf16* memkv; const float* logf; const float* onw; bf16* y; const float* kn; };

template <int MODE>
__device__ __forceinline__ void attn_unit(const Args& A, int b, int h, int qb, ALAS char* lds) {
    constexpr int KVP = (MODE == 2) ? 512 : NPROJ;
    constexpr int QCOL = MODE == 0 ? PC_SBQ : (MODE == 1 ? PC_FXQ : PC_MQ);
    constexpr int HG0 = MODE == 0 ? 0 : (MODE == 1 ? 8 : 16);
    int tid_ = threadIdx.x; asm volatile("" : "+v"(tid_));
    const int tid = tid_, lane = tid & 63, r32 = lane & 31, hi = lane >> 5; const int wid = __builtin_amdgcn_readfirstlane(tid >> 6);
    const int q0 = qb * 256;
    const int wrow = (MODE == 2) ? wid : (wid ^ ((wid >> 2) & 1));
    const size_t trow0 = (size_t)b * SEQ + q0 + wrow * 32;
    const bf16* Qw = A.proj + trow0 * NPROJ + QCOL + h * HDIM;
    const bf16* Kh = (MODE == 2) ? A.memkv + (size_t)b * MEM_LEN * 512 + h * HDIM : A.proj + (size_t)b * SEQ * NPROJ + (MODE == 0 ? PC_SBK : PC_FXK) + h * HDIM;
    const bf16* Vh = (MODE == 2) ? A.memkv + (size_t)b * MEM_LEN * 512 + 256 + h * HDIM : A.proj + (size_t)b * SEQ * NPROJ + (MODE == 0 ? PC_SBV : PC_FXV) + h * HDIM;
    const unsigned lds0 = (unsigned)(uintptr_t)lds;
    ALAS float* wsf = (ALAS float*)(lds + L_WS) + wid * 64;
    const int NT = (MODE == 2) ? 4 : 4 * qb + 4;
    if (MODE == 1) {
        ALAS float* cb = (ALAS float*)(lds + L_CB); ALAS float* sc = (ALAS float*)(lds + L_SC);
        const int n = 256 * (qb + 1); const float* lf = A.logf + (size_t)(b * 8 + h) * SEQ;
        f32x4 v = {0.f, 0.f, 0.f, 0.f}; if (4 * tid < n) v = *(const f32x4*)(lf + 4 * tid);
        const float a0 = v[0], a1 = a0 + v[1], a2 = a1 + v[2], a3 = a2 + v[3];
        float x = a3;
#pragma unroll
        for (int o = 1; o < 64; o <<= 1) { const float yv = __shfl_up(x, o); if (lane >= o) x += yv; }
        if (lane == 63) sc[wid] = x;
        asm volatile("s_waitcnt lgkmcnt(0)\n\ts_barrier" ::: "memory");
        float off = 0.f, tot = 0.f;
#pragma unroll
        for (int w = 0; w < 8; ++w) { const float sw = sc[w]; if (w < wid) off += sw; if (w < (n >> 8)) tot += sw; }
        const float ex = off + x - a3;
        if (4 * tid < n) { f32x4 cbv; cbv[0] = (tot - (ex + a0)) * LOG2E; cbv[1] = (tot - (ex + a1)) * LOG2E; cbv[2] = (tot - (ex + a2)) * LOG2E; cbv[3] = (tot - (ex + a3)) * LOG2E; *(ALAS f32x4*)(cb + 4 * tid) = cbv; }
    }
    const bf16* ksrc = Kh + (size_t)lane * KVP + wid * 8;
    const bf16* vsrc = Vh + (size_t)(16 * (wid & 3) + (lane >> 2)) * KVP + (wid >> 2) * 32 + (lane & 3) * 8;
    const unsigned kdst = lds0 + L_K + wid * 1024, vdst = lds0 + L_V + wid * 1024;
#define DMA_K(t, slot) glds16(ksrc + (size_t)(t) * 64 * KVP, (unsigned)__builtin_amdgcn_readfirstlane(kdst + (slot)))
#define DMA_V(t, slot) glds16(vsrc + (size_t)(t) * 64 * KVP, (unsigned)__builtin_amdgcn_readfirstlane(vdst + (slot)))
    bf16x8 qr[4];
#pragma unroll
    for (int d0 = 0; d0 < 4; ++d0) qr[d0] = *(const bf16x8*)(Qw + (size_t)r32 * NPROJ + d0 * 16 + hi * 8);
    const int hg = HG0 + h, ch = lane & 7;
    u32x4 gv[4];
#pragma unroll
    for (int i = 0; i < 4; ++i) gv[i] = *(const u32x4*)(A.proj + (trow0 + i * 8 + (lane >> 3)) * NPROJ + PC_GATE + hg * HDIM + ch * 8);
    const int vb0 = (int)(lds0 + L_V) + ((lane >> 4) & 1) * 32 + (lane & 3) * 8 + (4 * hi + ((lane & 15) >> 2)) * 64;
    const ALAS char* kp0 = lds + L_K + hi * 1024 + r32 * 16;
    f32x16 o[2]; o[0] = f32x16{}; o[1] = f32x16{};
    float mhat = -1e30f, l_reg = 0.f, carry = 0.f, smax = 0.f;
    const int qrel = wrow * 32 + r32;
    if (MODE == 1) {
        float qs = 0.f;
#pragma unroll
        for (int d0 = 0; d0 < 4; ++d0)
#pragma unroll
            for (int j = 0; j < 8; ++j) { const float qv = bf2f((unsigned short)qr[d0][j]); qs = fmaf(qv, qv, qs); }
        auto rr = __builtin_amdgcn_permlane32_swap(__float_as_uint(qs), __float_as_uint(qs), false, false);
        qs = __uint_as_float(rr[0]) + __uint_as_float(rr[1]);
        const float kn2 = A.kn[(b * 8 + h) * 2] + A.kn[(b * 8 + h) * 2 + 1];
        smax = sqrtf(qs * kn2) * 1.01f + 1e-3f;
    }
    f16x8 T0, T1, ONES;
    if (MODE == 0) {
#pragma unroll
        for (int j = 0; j < 8; ++j) { const int m0 = 8 * (j >> 2) + 4 * hi + (j & 3); T0[j] = (m0 >= r32) ? (_Float16)1.0f : (_Float16)0.0f; T1[j] = (16 + m0 >= r32) ? (_Float16)1.0f : (_Float16)0.0f; ONES[j] = (_Float16)1.0f; }
    }
    ALAS unsigned* flg = (ALAS unsigned*)(lds + L_FLG);
    const int tstart = (MODE == 2) ? NT - 1 : 4 * qb + (wrow >> 1);
    bool done = false;
    int t_hi = NT - 1;
    for (;;) {
        const int nres = t_hi + 1 < NRES ? t_hi + 1 : NRES, t_lo = t_hi - nres + 1;
        for (int j = 0; j < nres; ++j) { DMA_K(t_hi - j, j * SLOTB); DMA_V(t_hi - j, j * SLOTB); }
        AWAIT_BAR(0);
        if (!done) for (int t = (tstart < t_hi ? tstart : t_hi); t >= t_lo; --t) {
        const int slot = (t_hi - t) * SLOTB;
        const int jb = (MODE == 2) ? -1 : t - 4 * qb;
        f32x16 p0, p1;
        qkt(p0, p1, kp0 + slot, qr);
        if (MODE == 1) {
            const ALAS float* cbt = (const ALAS float*)(lds + L_CB) + 64 * t + 4 * hi;
#pragma unroll
            for (int g = 0; g < 4; ++g) { const f32x4 b0 = *(const ALAS f32x4*)(cbt + 8 * g), b1 = *(const ALAS f32x4*)(cbt + 32 + 8 * g);
#pragma unroll
                for (int e = 0; e < 4; ++e) { p0[4 * g + e] += b0[e]; p1[4 * g + e] += b1[e]; } }
        }
        if (MODE != 2 && jb >= 0) {
            const int kb = 64 * jb + 4 * hi, lim = (MODE == 0) ? qrel - 1 : qrel;
#pragma unroll
            for (int r = 0; r < 16; ++r) { const int kv = kb + (r & 3) + 8 * (r >> 2); if (kv > lim) p0[r] = -INFINITY; if (kv + 32 > lim) p1[r] = -INFINITY; }
        }
        if (MODE == 0) {
            f32x16 l0, l1;
#pragma unroll
            for (int r = 0; r < 16; ++r) { l0[r] = __builtin_amdgcn_logf(1.0f + __builtin_amdgcn_exp2f(p0[r])); l1[r] = __builtin_amdgcn_logf(1.0f + __builtin_amdgcn_exp2f(p1[r])); }
            u32x4 w0, w1, w2, w3;
            w0 = (u32x4){cvtpk_h(l0[0], l0[1]), cvtpk_h(l0[2], l0[3]), cvtpk_h(l0[4], l0[5]), cvtpk_h(l0[6], l0[7])};
            w1 = (u32x4){cvtpk_h(l0[8], l0[9]), cvtpk_h(l0[10], l0[11]), cvtpk_h(l0[12], l0[13]), cvtpk_h(l0[14], l0[15])};
            w2 = (u32x4){cvtpk_h(l1[0], l1[1]), cvtpk_h(l1[2], l1[3]), cvtpk_h(l1[4], l1[5]), cvtpk_h(l1[6], l1[7])};
            w3 = (u32x4){cvtpk_h(l1[8], l1[9]), cvtpk_h(l1[10], l1[11]), cvtpk_h(l1[12], l1[13]), cvtpk_h(l1[14], l1[15])};
            const f16x8 f0 = __builtin_bit_cast(f16x8, w0), f1 = __builtin_bit_cast(f16x8, w1), f2 = __builtin_bit_cast(f16x8, w2), f3 = __builtin_bit_cast(f16x8, w3);
            const f32x16 z = {};
            f32x16 ist = __builtin_amdgcn_mfma_f32_32x32x16_f16(T0, f0, z, 0, 0, 0);
            ist = __builtin_amdgcn_mfma_f32_32x32x16_f16(T1, f1, ist, 0, 0, 0);
            ist = __builtin_amdgcn_mfma_f32_32x32x16_f16(ONES, f2, ist, 0, 0, 0);
            ist = __builtin_amdgcn_mfma_f32_32x32x16_f16(ONES, f3, ist, 0, 0, 0);
            f32x16 isb = __builtin_amdgcn_mfma_f32_32x32x16_f16(T0, f2, z, 0, 0, 0);
            isb = __builtin_amdgcn_mfma_f32_32x32x16_f16(T1, f3, isb, 0, 0, 0);
#pragma unroll
            for (int r = 0; r < 16; ++r) { p0[r] = __builtin_amdgcn_exp2f((p0[r] - ist[r]) - carry); p1[r] = __builtin_amdgcn_exp2f((p1[r] - isb[r]) - carry); }
            const float tt = ist[0];
            carry += __shfl(tt, r32);
            done = __all(carry > 135.0f);
        } else {
            const float rm = rowmax(p0, p1);
            if (__any(rm > mhat + THR)) {
                const float mn = fmaxf(mhat, rm), f = __builtin_amdgcn_exp2f(mhat - mn);
                mhat = mn; l_reg *= f;
                if (hi == 0) wsf[r32] = f;
                asm volatile("s_waitcnt lgkmcnt(0)" ::: "memory");
#pragma unroll
                for (int r = 0; r < 16; ++r) { const float fr_ = wsf[crow(r, hi)]; o[0][r] *= fr_; o[1][r] *= fr_; }
            }
            float sacc = 0.f;
#pragma unroll
            for (int r = 0; r < 16; ++r) { p0[r] = __builtin_amdgcn_exp2f(p0[r] - mhat); p1[r] = __builtin_amdgcn_exp2f(p1[r] - mhat); sacc += p0[r] + p1[r]; }
            l_reg += sacc;
            if (MODE == 1 && t > 0) {
                const float cbn = *((const ALAS float*)(lds + L_CB) + 64 * t - 1);
                done = __all(smax + cbn - mhat < -135.0f);
            }
        }
        u32x4 pw0, pw1, pw2, pw3;
        pw0 = (u32x4){cvtpk_s(p0[0], p0[1]), cvtpk_s(p0[2], p0[3]), cvtpk_s(p0[4], p0[5]), cvtpk_s(p0[6], p0[7])};
        pw1 = (u32x4){cvtpk_s(p0[8], p0[9]), cvtpk_s(p0[10], p0[11]), cvtpk_s(p0[12], p0[13]), cvtpk_s(p0[14], p0[15])};
        pw2 = (u32x4){cvtpk_s(p1[0], p1[1]), cvtpk_s(p1[2], p1[3]), cvtpk_s(p1[4], p1[5]), cvtpk_s(p1[6], p1[7])};
        pw3 = (u32x4){cvtpk_s(p1[8], p1[9]), cvtpk_s(p1[10], p1[11]), cvtpk_s(p1[12], p1[13]), cvtpk_s(p1[14], p1[15])};
        __builtin_amdgcn_sched_barrier(0);
        pv(o, vb0 + slot, __builtin_bit_cast(bf16x8, pw0), __builtin_bit_cast(bf16x8, pw1), __builtin_bit_cast(bf16x8, pw2), __builtin_bit_cast(bf16x8, pw3));
        if (done) break;
        }
        if (lane == 0) flg[wid] = done ? 1u : 0u;
        asm volatile("s_waitcnt lgkmcnt(0)\n\ts_barrier" ::: "memory");
        if (t_lo == 0) break;
        unsigned nd = 0;
#pragma unroll
        for (int w = 0; w < 8; ++w) nd += flg[w];
        if (__builtin_amdgcn_readfirstlane(nd) == 8u) break;
        t_hi = t_lo - 1;
    }
#undef DMA_K
#undef DMA_V
    float rl[16];
    if (MODE != 0) {
        auto rr = __builtin_amdgcn_permlane32_swap(__float_as_uint(l_reg), __float_as_uint(l_reg), false, false);
        const float lt = __uint_as_float(rr[0]) + __uint_as_float(rr[1]);
        if (hi == 0) wsf[32 + r32] = lt;
        asm volatile("s_waitcnt lgkmcnt(0)" ::: "memory");
#pragma unroll
        for (int r = 0; r < 16; ++r) rl[r] = __builtin_amdgcn_rcpf(wsf[32 + crow(r, hi)]);
    } else {
#pragma unroll
        for (int r = 0; r < 16; ++r) rl[r] = 1.0f;
    }
    ALAS float* stg = (ALAS float*)(lds + L_K + wid * OSTW);
#pragma unroll
    for (int r = 0; r < 16; ++r) { const int orow = crow(r, hi);
#pragma unroll
        for (int d0 = 0; d0 < 2; ++d0) stg[orow * 68 + d0 * 32 + r32] = o[d0][r] * rl[r]; }
    asm volatile("s_waitcnt lgkmcnt(0)" ::: "memory");
    const f32x4 nw0 = *(const f32x4*)(A.onw + hg * HDIM + ch * 8), nw1 = *(const f32x4*)(A.onw + hg * HDIM + ch * 8 + 4);
#pragma unroll
    for (int i = 0; i < 4; ++i) {
        const int row = i * 8 + (lane >> 3);
        const f32x4 a = *(const ALAS f32x4*)(stg + row * 68 + ch * 8), c = *(const ALAS f32x4*)(stg + row * 68 + ch * 8 + 4);
        float ss = (a[0] * a[0] + a[1] * a[1]) + (a[2] * a[2] + a[3] * a[3]) + (c[0] * c[0] + c[1] * c[1]) + (c[2] * c[2] + c[3] * c[3]);
        ss += __shfl_xor(ss, 1); ss += __shfl_xor(ss, 2); ss += __shfl_xor(ss, 4);
        const float rstd = rsqrtf(ss * (1.0f / HDIM) + EPS);
        const size_t grow = trow0 + row;
        float g[8];
#pragma unroll
        for (int e = 0; e < 4; ++e) { g[2 * e] = __uint_as_float(gv[i][e] << 16); g[2 * e + 1] = __uint_as_float(gv[i][e] & 0xffff0000u); }
        float ov[8];
#pragma unroll
        for (int e = 0; e < 8; ++e) { const float val = (e < 4 ? a[e] : c[e - 4]) * rstd * (e < 4 ? nw0[e] : nw1[e - 4]); const float sg = g[e] * __builtin_amdgcn_rcpf(1.0f + __builtin_amdgcn_exp2f(-LOG2E * g[e])); ov[e] = val * sg; }
        u32x4 w; w.x = cvtpk_s(ov[0], ov[1]); w.y = cvtpk_s(ov[2], ov[3]); w.z = cvtpk_s(ov[4], ov[5]); w.w = cvtpk_s(ov[6], ov[7]);
        *(u32x4*)(A.y + grow * MIX_W + hg * HDIM + ch * 8) = w;
    }
    asm volatile("s_waitcnt lgkmcnt(0)\n\ts_barrier" ::: "memory");
}
#undef AWAIT_BAR
}
constexpr int NWAVES = 8;
#ifndef PROBE_P1_REPS
#define PROBE_P1_REPS 1
#endif
#ifndef PROBE_P0_REPS
#define PROBE_P0_REPS 1
#endif
#ifndef PROBE_P3_REPS
#define PROBE_P3_REPS 1
#endif
#ifndef PROBE_SB_REPS
#define PROBE_SB_REPS 1
#endif
#ifndef PROBE_FX_REPS
#define PROBE_FX_REPS 1
#endif
#ifndef PROBE_MEM_REPS
#define PROBE_MEM_REPS 1
#endif
#ifndef PROBE_P2_REPS
#define PROBE_P2_REPS 1
#endif
constexpr size_t MiB = 1u << 20;
constexpr size_t WS_CTL = 0, CTL_ZERO_BYTES = 64 * 1024;
constexpr size_t WS_WIN0 = 1 * MiB;
constexpr size_t WS_WIN1 = 13 * MiB;
constexpr size_t WS_WOUT = 23 * MiB;
constexpr size_t WS_XB = 28 * MiB;
constexpr size_t WS_PROJ = 64 * MiB;
constexpr size_t WS_Y = 208 * MiB;
constexpr size_t WS_MEMKV = 248 * MiB;
constexpr size_t WS_LOGF = 252 * MiB;
constexpr size_t WS_ST0 = 252 * MiB + 512 * 1024;
constexpr size_t WS_ST1 = WS_ST0 + (size_t)M_CAT * 64 + 64 * 1024;
constexpr size_t WS_ST2 = WS_ST1 + (size_t)M_TOK * 64;
constexpr size_t WS_END = WS_ST2 + (size_t)M_TOK * 64;
static_assert(WS_WIN0 + (size_t)(NPAD + 1024) * 1024 * 2 <= WS_WIN1 && WS_WIN1 + (size_t)NPAD * 1024 * 2 <= WS_WOUT && WS_WOUT + 2ull * 1024 * 1280 * 2 <= WS_XB &&
              WS_XB + (size_t)M_CAT * 1024 * 2 <= WS_PROJ && WS_PROJ + (size_t)M_TOK * NPROJ * 2 <= WS_Y && WS_Y + (size_t)M_TOK * MIX_W * 2 <= WS_MEMKV &&
              WS_MEMKV + 2ull * M_MEM * 512 * 2 <= WS_LOGF && WS_LOGF + 8ull * 8 * SEQ * 4 <= WS_ST0 && WS_END <= 256 * MiB, "d_ws map");
constexpr int CW_KN = 8192;
constexpr int CW_BAR = 1024;
static_assert((CW_BAR + XCD_BAR_WORDS) * 4 <= (int)CTL_ZERO_BYTES, "control words inside the memset region");
constexpr int RING_BYTES = 131072, MISC_OFF = RING_BYTES + 320, LDS_BYTES = 147456;
static_assert(att::L_END <= RING_BYTES, "attention scratch fits the ring region");

struct KArgs { const float* in[10]; float* out; unsigned char* ws; };

__device__ __forceinline__ float wave_sum(float v) {
#pragma unroll
    for (int o = 1; o < 64; o <<= 1) v += __shfl_xor(v, o);
    return v;
}
__device__ __forceinline__ void p0_item(const float* W, int N, int col0, int nvalid, const float* g, bf16* WT, int K, int drow0, int k0, LAS float* scr, int lane) {
    float vv[32]; const int c = lane & 31, kh = lane >> 5;
    if (c < nvalid) {
#pragma unroll
        for (int i = 0; i < 32; ++i) vv[i] = W[(size_t)(k0 + 2 * i + kh) * N + col0 + c];
        if (g) {
#pragma unroll
            for (int i = 0; i < 32; ++i) vv[i] *= g[k0 + 2 * i + kh]; }
    } else {
#pragma unroll
        for (int i = 0; i < 32; ++i) vv[i] = 0.f; }
#pragma unroll
    for (int i = 0; i < 32; ++i) scr[(2 * i + kh) * 33 + c] = vv[i];
    LDS_WAIT(); asm volatile("" ::: "memory");
    const int c8 = lane & 7;
#pragma unroll
    for (int j = 0; j < 4; ++j) { const int n = (lane >> 3) + 8 * j; const LAS float* s = scr + (8 * c8) * 33 + n;
        v4u o; o.x = pk2(s[0 * 33], s[1 * 33]); o.y = pk2(s[2 * 33], s[3 * 33]); o.z = pk2(s[4 * 33], s[5 * 33]); o.w = pk2(s[6 * 33], s[7 * 33]);
        *(GAS v4u*)(WT + (size_t)(drow0 + n) * K + k0 + 8 * c8) = o; }
    LDS_WAIT(); asm volatile("" ::: "memory");
}

__global__ void __launch_bounds__(NWAVES * 64, 2) mega_fwd(KArgs args) {
    extern __shared__ __attribute__((aligned(16))) unsigned char lds_raw[];
    LAS unsigned char* lds = (LAS unsigned char*)lds_raw;
    volatile LAS unsigned* MISC = (volatile LAS unsigned*)(lds + MISC_OFF);
    const int tid = threadIdx.x, lane = tid & 63, wave = __builtin_amdgcn_readfirstlane(tid >> 6);
    const int G = gridDim.x, bx = blockIdx.x, vcu = (G % 8 == 0) ? (bx % 8) * (G / 8) + bx / 8 : bx;
    unsigned char* ws = args.ws;
    const float* x = args.in[0]; const float* mem = args.in[1]; const float* norm_w = args.in[2]; const float* w_in = args.in[3]; const float* b_forget = args.in[4];
    const float* mem_norm_w = args.in[5]; const float* w_mem_kv = args.in[6]; const float* out_norm_w = args.in[7]; const float* w_out = args.in[8]; const float* final_norm_w = args.in[9];
    float* out = args.out;
    bf16* WIN0 = (bf16*)(ws + WS_WIN0); bf16* WIN1 = (bf16*)(ws + WS_WIN1); bf16* WOUT = (bf16*)(ws + WS_WOUT); bf16* XB = (bf16*)(ws + WS_XB);
    bf16* PROJ = (bf16*)(ws + WS_PROJ); bf16* Y = (bf16*)(ws + WS_Y); bf16* MEMKV = (bf16*)(ws + WS_MEMKV);
    float* LOGF = (float*)(ws + WS_LOGF); float* ST0 = (float*)(ws + WS_ST0); float* ST1 = (float*)(ws + WS_ST1); float* ST2 = (float*)(ws + WS_ST2);
    for (int u = tid; u < (LDS_BYTES - RING_BYTES) / 4; u += NWAVES * 64) ((LAS unsigned*)(lds + RING_BYTES))[u] = 0u;
    __syncthreads();
    XcdBarrier bar = xcd_barrier_post((unsigned*)(ws + WS_CTL) + CW_BAR, MISC + 8);
    const int gw = vcu * NWAVES + wave, NGW = G * NWAVES;

    for (int rep0_ = 0; rep0_ < PROBE_P0_REPS; ++rep0_) {
        LAS float* scr = (LAS float*)(lds + wave * 16384);
        constexpr int I_IN = (NPAD / 32) * (D_MODEL / 64), I_MKV = (512 / 32) * (D_MODEL / 64), I_OUT = (D_MODEL / 32) * (MIX_W / 64), I_L = I_IN + I_MKV + I_OUT;
        for (int it = gw; it < 2 * I_L; it += NGW) {
            const int l = it / I_L; int r = it - l * I_L;
            if (r < I_IN) { const int nb = r % (NPAD / 32), kb = r / (NPAD / 32), n0 = 32 * nb;
                int col0, nv; if (n0 < 3072) { col0 = n0; nv = 32; } else if (n0 < NPROJ) { col0 = n0 + 8; nv = 32; } else if (n0 == NPROJ) { col0 = 3072; nv = 8; } else { col0 = 0; nv = 0; }
                p0_item(w_in + (size_t)l * D_MODEL * IN_W, IN_W, col0, nv, norm_w + l * D_MODEL, l == 0 ? WIN0 : WIN1, D_MODEL, n0, 64 * kb, scr, lane); continue; }
            r -= I_IN;
            if (r < I_MKV) { const int nb = r % 16, kb = r / 16;
                p0_item(w_mem_kv + (size_t)l * D_MODEL * 512, 512, 32 * nb, 32, mem_norm_w + l * D_MODEL, WIN0, D_MODEL, NPAD + l * 512 + 32 * nb, 64 * kb, scr, lane); continue; }
            r -= I_MKV;
            { const int nb = r % 32, kb = r / 32;
                p0_item(w_out + (size_t)l * MIX_W * D_MODEL, D_MODEL, 32 * nb, 32, nullptr, WOUT + (size_t)l * D_MODEL * MIX_W, MIX_W, 32 * nb, 64 * kb, scr, lane); }
        }
        for (int m0 = gw; m0 < M_CAT; m0 += 3 * NGW) {
            f32x4 v[3][4];
#pragma unroll
            for (int q = 0; q < 3; ++q) { const int m = m0 + q * NGW;
                if (m < M_CAT) { const float* src = m < M_TOK ? x + (size_t)m * D_MODEL : mem + (size_t)(m - M_TOK) * D_MODEL; const GAS f32x4* xr = (const GAS f32x4*)src + lane;
#pragma unroll
                    for (int j = 0; j < 4; ++j) v[q][j] = xr[64 * j]; } }
#pragma unroll
            for (int q = 0; q < 3; ++q) { const int m = m0 + q * NGW;
                if (m < M_CAT) { float s = 0.f;
#pragma unroll
                    for (int j = 0; j < 4; ++j) s += (v[q][j].x * v[q][j].x + v[q][j].y * v[q][j].y) + (v[q][j].z * v[q][j].z + v[q][j].w * v[q][j].w);
                    s = wave_sum(s);
                    GAS unsigned long long* o8 = (GAS unsigned long long*)(XB + (size_t)m * D_MODEL) + lane;
#pragma unroll
                    for (int j = 0; j < 4; ++j) o8[64 * j] = (unsigned long long)pk2(v[q][j].x, v[q][j].y) | ((unsigned long long)pk2(v[q][j].z, v[q][j].w) << 32);
                    if (lane < 16) ST0[(size_t)m * 16 + lane] = lane == 0 ? s : 0.f; } }
        }
    }
    xcd_barrier(bar);

    for (int layer = 0; layer < DEPTH; ++layer) {
        {
            pg8::Gemm g{XB, layer == 0 ? WIN0 : WIN1, M_CAT, NPAD, D_MODEL};
            pg8::OrderP1 S; S.init(G, bx, layer == 0 ? 32 : 0);
            pg8::EpiP1 E{PROJ, MEMKV, LOGF, layer == 0 ? ST0 : ST1, b_forget + layer * 8, (unsigned*)(ws + WS_CTL) + CW_KN + layer * 128};
            for (int rep_ = 0; rep_ < PROBE_P1_REPS; ++rep_)
            pg8::gemm_phase<pg8::EpiP1, pg8::OrderP1, true, true>(lds, g, S, E);
        }
        xcd_barrier(bar);
        {
            const att::Args A{PROJ, MEMKV + (size_t)layer * M_MEM * 512, LOGF, out_norm_w + layer * MIX_W, Y, (const float*)((unsigned*)(ws + WS_CTL) + CW_KN + layer * 128)};
            for (int rep_ = 0; rep_ < PROBE_P2_REPS; ++rep_)
            for (int slot = vcu; slot < 256; slot += G) {
                const int bh = slot >> 2, b = bh >> 3, h = bh & 7, s = slot & 3;
                for (int r_ = 0; r_ < PROBE_SB_REPS; ++r_) {
                att::attn_unit<0>(A, b, h, 7 - s, (LAS char*)lds);
                att::attn_unit<0>(A, b, h, s, (LAS char*)lds); }
                for (int r_ = 0; r_ < PROBE_FX_REPS; ++r_) {
                att::attn_unit<1>(A, b, h, 7 - s, (LAS char*)lds);
                att::attn_unit<1>(A, b, h, s, (LAS char*)lds); }
                for (int r_ = 0; r_ < PROBE_MEM_REPS; ++r_)
                att::attn_unit<2>(A, slot >> 5, (slot >> 3) & 3, slot & 7, (LAS char*)lds);
            }
        }
        xcd_barrier(bar);
        {
            pg8::Gemm g{Y, WOUT + (size_t)layer * D_MODEL * MIX_W, M_TOK, D_MODEL, MIX_W};
            pg8::StaticOrder S; S.init(M_TOK, D_MODEL, G, bx);
            pg8::EpiP3 E{layer == 0 ? x : out, out, XB, layer == 0 ? ST1 : ST2};
            for (int rep_ = 0; rep_ < (layer == 0 ? PROBE_P3_REPS : 1); ++rep_)
            pg8::gemm_phase<pg8::EpiP3, pg8::StaticOrder, true, true>(lds, g, S, E);
        }
        xcd_barrier(bar);
    }
    for (int m = gw; m < M_TOK; m += NGW) {
        const float rstd = pg8::row_rstd(ST2, m);
        GAS f32x4* xr = (GAS f32x4*)(out + (size_t)m * D_MODEL) + lane;
        const GAS f32x4* gr = (const GAS f32x4*)final_norm_w + lane;
#pragma unroll
        for (int j = 0; j < 4; ++j) { const f32x4 v = xr[64 * j], gg = gr[64 * j]; xr[64 * j] = v * rstd * gg; }
    }
}

extern "C" void kernel_launch(void* const* d_in, const int* in_sizes, int n_in, void* d_out, int out_size, void* d_ws, size_t ws_size, hipStream_t stream) {
    static int grid = 0;
    if (grid == 0) {
        if (n_in != 10 || out_size != M_TOK * D_MODEL || ws_size < WS_END) { fprintf(stderr, "kernel_launch: unexpected shapes / workspace (%d inputs, out %d, ws %zu, need %zu)\n", n_in, out_size, ws_size, (size_t)WS_END); grid = -1; return; }
        int dev = 0, cus = 0, per_cu = 0;
        if (hipGetDevice(&dev) != hipSuccess || hipDeviceGetAttribute(&cus, hipDeviceAttributeMultiprocessorCount, dev) != hipSuccess) { grid = -1; return; }
        if (hipFuncSetAttribute((const void*)mega_fwd, hipFuncAttributeMaxDynamicSharedMemorySize, LDS_BYTES) != hipSuccess) { fprintf(stderr, "kernel_launch: hipFuncSetAttribute failed\n"); grid = -1; return; }
        if (hipOccupancyMaxActiveBlocksPerMultiprocessor(&per_cu, (const void*)mega_fwd, NWAVES * 64, LDS_BYTES) != hipSuccess || per_cu < 1) { fprintf(stderr, "kernel_launch: occupancy query says %d blocks per CU\n", per_cu); (void)hipGetLastError(); grid = -1; return; }
        grid = cus;
    }
    if (grid < 0) return;
    if (hipMemsetAsync((char*)d_ws + WS_CTL, 0, CTL_ZERO_BYTES, stream) != hipSuccess) return;
    KArgs a{};
    for (int i = 0; i < 10; ++i) a.in[i] = (const float*)d_in[i];
    a.out = (float*)d_out; a.ws = (unsigned char*)d_ws;
    hipLaunchKernelGGL(mega_fwd, dim3(grid), dim3(NWAVES * 64), LDS_BYTES, stream, a);
}
```
